# Optimizing an MI355X kernel written in HIP

```python
import math
import jax, jax.numpy as jnp
from jax import lax
import numpy as np

D_MODEL = 1024
BATCH = 32
SEQ = 2048
DEPTH = 1
DEC_BATCH = 16
DEC_SEQ = 4096
PAST_LEN = 128

D_MIX = D_MODEL
D_SSM = D_MIX // 2
D_ATTN = D_MIX - D_SSM
SSM_GROUP = 16
N_SSM_GROUPS = D_SSM // SSM_GROUP
SSM_STATE = 64
HEAD_DIM = 64
N_HEADS = D_ATTN // HEAD_DIM
N_KV_HEADS = 2
GQA_GROUP = N_HEADS // N_KV_HEADS
WINDOW = 128
BLOCK = 128
N_BUCKETS = 32
MAX_DISTANCE = 128
RMS_EPS = 1e-6
NEG_INF = -1e30
STEP_MIN = 0.001
STEP_MAX = 0.1
D_IN_PROJ = 2 * D_SSM + D_ATTN + 2 * N_KV_HEADS * HEAD_DIM + D_ATTN
SPLITS = (D_SSM, 2 * D_SSM, 2 * D_SSM + D_ATTN,
          2 * D_SSM + D_ATTN + N_KV_HEADS * HEAD_DIM,
          2 * D_SSM + D_ATTN + 2 * N_KV_HEADS * HEAD_DIM)

kernel_name = "hymba_s5_window_gqa_encoder"


def _rmsnorm(x, w):
    xf = x.astype(jnp.float32)
    y = xf * lax.rsqrt(jnp.mean(xf * xf, axis=-1, keepdims=True) + RMS_EPS)
    return (y * w.astype(jnp.float32)).astype(x.dtype)


def _t5_buckets(rel):
    half = N_BUCKETS // 2
    max_exact = half // 2
    ret = jnp.where(rel > 0, half, 0)
    n = jnp.abs(rel)
    nf = jnp.maximum(n, 1).astype(jnp.float32)
    large = max_exact + (jnp.log(nf / max_exact) / math.log(MAX_DISTANCE / max_exact)
                         * (half - max_exact)).astype(jnp.int32)
    large = jnp.minimum(large, half - 1)
    return ret + jnp.where(n < max_exact, n, large)


def _ssm_direction(u, lam_re, lam_im, log_step, b_re, b_im, c_re, c_im, reverse):
    f32 = jnp.float32
    lam_re = lam_re.astype(f32); lam_im = lam_im.astype(f32)
    dt = jnp.exp(log_step.astype(f32))[:, None]
    mag = jnp.exp(lam_re * dt)
    lb_re = mag * jnp.cos(lam_im * dt)
    lb_im = mag * jnp.sin(lam_im * dt)
    den = lam_re * lam_re + lam_im * lam_im
    nr = lb_re - 1.0
    coef_re = ((nr * lam_re + lb_im * lam_im) / den)[..., None]
    coef_im = ((lb_im * lam_re - nr * lam_im) / den)[..., None]
    b_re = b_re.astype(f32); b_im = b_im.astype(f32)
    bb_re = coef_re * b_re - coef_im * b_im
    bb_im = coef_re * b_im + coef_im * b_re
    bu_re = jnp.einsum('blgh,gph->blgp', u, bb_re)
    bu_im = jnp.einsum('blgh,gph->blgp', u, bb_im)
    a_re = jnp.broadcast_to(lb_re, bu_re.shape)
    a_im = jnp.broadcast_to(lb_im, bu_im.shape)

    def combine(e1, e2):
        a1r, a1i, b1r, b1i = e1
        a2r, a2i, b2r, b2i = e2
        return (a2r * a1r - a2i * a1i,
                a2r * a1i + a2i * a1r,
                a2r * b1r - a2i * b1i + b2r,
                a2r * b1i + a2i * b1r + b2i)

    _, _, s_re, s_im = lax.associative_scan(combine, (a_re, a_im, bu_re, bu_im),
                                            axis=1, reverse=reverse)
    return (jnp.einsum('blgp,ghp->blgh', s_re, c_re.astype(f32))
            - jnp.einsum('blgp,ghp->blgh', s_im, c_im.astype(f32)))


def _ssm_branch(u, lam_re, lam_im, log_step, b_re, b_im, c_re, c_im, d_skip, w_glu, b_glu):
    b, l, _ = u.shape
    ug = u.reshape(b, l, N_SSM_GROUPS, SSM_GROUP).astype(jnp.float32)
    y = d_skip.astype(jnp.float32) * ug
    for d in range(2):
        y = y + _ssm_direction(ug, lam_re[d], lam_im[d], log_step[d], b_re[d], b_im[d],
                               c_re[d], c_im[d], reverse=(d == 1))
    y = y.reshape(b, l, D_SSM).astype(u.dtype)
    g = jax.nn.gelu(y)
    return g * jax.nn.sigmoid(g @ w_glu + b_glu)


def _attn_branch(q, k, v, sink, rel_bias):
    b, l, _ = q.shape
    nb = l // BLOCK
    qb = q.reshape(b, nb, BLOCK, N_KV_HEADS, GQA_GROUP, HEAD_DIM)

    def band(t):
        tp = jnp.pad(t.reshape(b, l, N_KV_HEADS, HEAD_DIM), ((0, 0), (BLOCK, BLOCK), (0, 0), (0, 0)))
        tp = tp.reshape(b, nb + 2, BLOCK, N_KV_HEADS, HEAD_DIM)
        return jnp.concatenate([tp[:, :-2], tp[:, 1:-1], tp[:, 2:]], axis=2)

    kw = band(k)
    vw = band(v)
    q_idx = jnp.arange(BLOCK, dtype=jnp.int32)[:, None]
    s_idx = jnp.arange(3 * BLOCK, dtype=jnp.int32)[None, :]
    rel = s_idx - BLOCK - q_idx
    bias = rel_bias.astype(jnp.float32)[_t5_buckets(rel)]
    bias = jnp.transpose(bias, (2, 0, 1)).reshape(N_KV_HEADS, GQA_GROUP, BLOCK, 3 * BLOCK)
    kpos = jnp.arange(nb, dtype=jnp.int32)[:, None, None] * BLOCK + s_idx[None] - BLOCK
    valid = (jnp.abs(rel) <= WINDOW)[None] & (kpos >= 0) & (kpos < l)

    scores = jnp.einsum('bnqkgd,bnskd->bnkgqs', qb, kw, preferred_element_type=jnp.float32)
    scores = scores * (HEAD_DIM ** -0.5) + bias
    scores = jnp.where(valid[None, :, None, None], scores, NEG_INF)
    sink_l = sink.astype(jnp.float32).reshape(N_KV_HEADS, GQA_GROUP, 1, 1)
    m = jnp.maximum(jnp.max(scores, axis=-1, keepdims=True), sink_l)
    p = jnp.exp(scores - m)
    denom = jnp.sum(p, axis=-1, keepdims=True) + jnp.exp(sink_l - m)
    probs = (p / denom).astype(v.dtype)
    out = jnp.einsum('bnkgqs,bnskd->bnqkgd', probs, vw)
    return out.reshape(b, l, D_ATTN)


def _layer(x, norm_w, w_in, lam_re, lam_im, log_step, b_re, b_im, c_re, c_im, d_skip,
           w_glu, b_glu, ssm_norm_w, sink, attn_norm_w, w_out, rel_bias):
    h = _rmsnorm(x, norm_w)
    proj = h @ w_in
    u_ssm, z_ssm, q, k, v, z_attn = jnp.split(proj, SPLITS, axis=-1)
    y_ssm = _ssm_branch(u_ssm, lam_re, lam_im, log_step, b_re, b_im, c_re, c_im, d_skip, w_glu, b_glu)
    y_attn = _attn_branch(q, k, v, sink, rel_bias)
    mixed = jnp.concatenate([_rmsnorm(y_ssm, ssm_norm_w) * jax.nn.silu(z_ssm),
                             _rmsnorm(y_attn, attn_norm_w) * jax.nn.silu(z_attn)], axis=-1)
    return x + mixed @ w_out


def _encoder(x, norm_w, w_in, lam_re, lam_im, log_step, b_re, b_im, c_re, c_im, d_skip,
             w_glu, b_glu, ssm_norm_w, sink, attn_norm_w, w_out, rel_bias, final_norm_w):
    for i in range(DEPTH):
        x = _layer(x, norm_w[i], w_in[i], lam_re[i], lam_im[i], log_step[i], b_re[i], b_im[i],
                   c_re[i], c_im[i], d_skip[i], w_glu[i], b_glu[i], ssm_norm_w[i], sink[i],
                   attn_norm_w[i], w_out[i], rel_bias)
    return _rmsnorm(x, final_norm_w)


def setup_inputs(seed: int = 0) -> dict:
    key = jax.random.key(seed)
    ks = jax.random.split(key, 24)
    f32 = jnp.float32
    G, P, H = N_SSM_GROUPS, SSM_STATE, SSM_GROUP
    nrm = lambda k, s: jax.random.normal(k, s, f32)
    x_prompt = nrm(ks[0], (BATCH, SEQ, D_MODEL))
    x_sample = nrm(ks[1], (DEC_BATCH, DEC_SEQ, D_MODEL))
    norm_w = 1.0 + 0.02 * nrm(ks[2], (DEPTH, D_MODEL))
    w_in = nrm(ks[3], (DEPTH, D_MODEL, D_IN_PROJ)) * D_MODEL ** -0.5
    lam_re = -0.5 + 0.01 * nrm(ks[4], (DEPTH, 2, G, P))
    lam_im = math.pi * jnp.arange(P, dtype=f32) + 0.01 * nrm(ks[5], (DEPTH, 2, G, P))
    log_step = jax.random.uniform(ks[6], (DEPTH, 2, G), f32, math.log(STEP_MIN), math.log(STEP_MAX))
    b_re = nrm(ks[7], (DEPTH, 2, G, P, H)) * (2 * H) ** -0.5
    b_im = nrm(ks[8], (DEPTH, 2, G, P, H)) * (2 * H) ** -0.5
    c_re = nrm(ks[9], (DEPTH, 2, G, H, P)) * (2 * P) ** -0.5
    c_im = nrm(ks[10], (DEPTH, 2, G, H, P)) * (2 * P) ** -0.5
    d_skip = nrm(ks[11], (DEPTH, G, H))
    w_glu = nrm(ks[12], (DEPTH, D_SSM, D_SSM)) * D_SSM ** -0.5
    b_glu = 0.02 * nrm(ks[13], (DEPTH, D_SSM))
    ssm_norm_w = 1.0 + 0.02 * nrm(ks[14], (DEPTH, D_SSM))
    sink = 0.5 * nrm(ks[15], (DEPTH, N_HEADS))
    attn_norm_w = 1.0 + 0.02 * nrm(ks[16], (DEPTH, D_ATTN))
    w_out = nrm(ks[17], (DEPTH, D_MIX, D_MODEL)) * D_MIX ** -0.5
    rel_bias = 0.1 * nrm(ks[18], (N_BUCKETS, N_HEADS))
    final_norm_w = 1.0 + 0.02 * nrm(ks[19], (D_MODEL,))
    return {"x_prompt": x_prompt, "x_sample": x_sample, "norm_w": norm_w, "w_in": w_in,
            "lam_re": lam_re, "lam_im": lam_im, "log_step": log_step, "b_re": b_re, "b_im": b_im,
            "c_re": c_re, "c_im": c_im, "d_skip": d_skip, "w_glu": w_glu, "b_glu": b_glu,
            "ssm_norm_w": ssm_norm_w, "sink": sink, "attn_norm_w": attn_norm_w, "w_out": w_out,
            "rel_bias": rel_bias, "final_norm_w": final_norm_w}


def reference(x_prompt, x_sample, norm_w, w_in, lam_re, lam_im, log_step, b_re, b_im, c_re, c_im,
              d_skip, w_glu, b_glu, ssm_norm_w, sink, attn_norm_w, w_out, rel_bias, final_norm_w):
    y_prompt = _encoder(x_prompt, norm_w, w_in, lam_re, lam_im, log_step, b_re, b_im, c_re, c_im,
                        d_skip, w_glu, b_glu, ssm_norm_w, sink, attn_norm_w, w_out, rel_bias, final_norm_w)
    y_sample = _encoder(x_sample, norm_w, w_in, lam_re, lam_im, log_step, b_re, b_im, c_re, c_im,
                        d_skip, w_glu, b_glu, ssm_norm_w, sink, attn_norm_w, w_out, rel_bias, final_norm_w)
    return (y_prompt, y_sample)
```

```cpp
#include <hip/hip_runtime.h>
#include <stdint.h>
#include <stdio.h>

typedef unsigned short bf16_t;
typedef short bf16x8 __attribute__((ext_vector_type(8)));
typedef float f32x16 __attribute__((ext_vector_type(16)));
typedef float f32x4 __attribute__((ext_vector_type(4)));

constexpr int M_TOK = 131072;
constexpr int M_PROMPT = 65536;
constexpr int DM = 1024;
constexpr int NPROJ = 2304;
constexpr float RMS_EPS = 1e-6f;

__device__ __forceinline__ bf16_t f2bf(float f) { uint32_t u = __float_as_uint(f); u += 0x7fffu + ((u >> 16) & 1u); return (bf16_t)(u >> 16); }
__device__ __forceinline__ float bf2f(bf16_t b) { return __uint_as_float(((uint32_t)b) << 16); }
__device__ __forceinline__ float silu_f(float v) { return v / (1.0f + __expf(-v)); }
__device__ __forceinline__ float sigmoid_f(float v) { return 1.0f / (1.0f + __expf(-v)); }
__device__ __forceinline__ float gelu_tanh_f(float x) { const float u = 0.7978845608028654f * (x + 0.044715f * x * x * x); return 0.5f * x * (1.0f + tanhf(u)); }
__device__ __forceinline__ void tok_seq(int t, int& start, int& len) {
    if (t < M_PROMPT) { len = 2048; start = t & ~2047; } else { len = 4096; start = M_PROMPT + ((t - M_PROMPT) & ~4095); }
}

constexpr size_t MiB = 1024 * 1024;
constexpr size_t OFF_A    = 0;
constexpr size_t OFF_UGM  = 256 * MiB;
constexpr size_t OFF_SZ   = OFF_UGM + 128 * MiB;
constexpr size_t OFF_Q    = OFF_SZ + 128 * MiB;
constexpr size_t OFF_KB   = OFF_Q + 128 * MiB;
constexpr size_t OFF_VT   = OFF_KB + 32 * MiB;
constexpr size_t OFF_AZ   = OFF_VT + 32 * MiB;
constexpr size_t OFF_G    = OFF_AZ + 128 * MiB;
constexpr size_t OFF_WIN  = OFF_G + 128 * MiB;
constexpr size_t OFF_WGLU = OFF_WIN + 5 * MiB;
constexpr size_t OFF_WOUT = OFF_WGLU + 1 * MiB;
constexpr size_t OFF_RSQ1 = OFF_WOUT + 2 * MiB;
constexpr size_t OFF_RSQ2 = OFF_RSQ1 + 512 * 1024;
constexpr size_t OFF_END  = OFF_RSQ2 + 512 * 1024;

__global__ void prep_wT(const float* __restrict__ w, int K, int N, const float* __restrict__ s1, const float* __restrict__ s2, int ksplit, bf16_t* __restrict__ out) {
    __shared__ float tile[32][33];
    const int k0 = blockIdx.y * 32, n0 = blockIdx.x * 32, tx = threadIdx.x & 31, ty = threadIdx.x >> 5;
    for (int i = ty; i < 32; i += 8) {
        const int k = k0 + i; float sc = 1.0f;
        if (s1) sc = (k < ksplit) ? s1[k] : s2[k - ksplit];
        tile[i][tx] = w[(size_t)k * N + n0 + tx] * sc;
    }
    __syncthreads();
    for (int i = ty; i < 32; i += 8) out[(size_t)(n0 + i) * K + k0 + tx] = f2bf(tile[tx][i]);
}

__global__ __launch_bounds__(256) void k_rmsnorm_in(const float* __restrict__ xp, const float* __restrict__ xs, bf16_t* __restrict__ h) {
    const int t = blockIdx.x * 4 + (threadIdx.x >> 6), lane = threadIdx.x & 63;
    const float* x = (t < M_PROMPT) ? xp + (size_t)t * DM : xs + (size_t)(t - M_PROMPT) * DM;
    f32x4 v[4]; float s = 0.f;
#pragma unroll
    for (int j = 0; j < 4; ++j) { v[j] = *(const f32x4*)(x + j * 256 + lane * 4); s += v[j][0] * v[j][0] + v[j][1] * v[j][1] + v[j][2] * v[j][2] + v[j][3] * v[j][3]; }
#pragma unroll
    for (int o = 32; o >= 1; o >>= 1) s += __shfl_xor(s, o);
    const float rs = rsqrtf(s * (1.0f / DM) + RMS_EPS);
#pragma unroll
    for (int j = 0; j < 4; ++j) {
        uint2 w; w.x = (uint32_t)f2bf(v[j][0] * rs) | ((uint32_t)f2bf(v[j][1] * rs) << 16); w.y = (uint32_t)f2bf(v[j][2] * rs) | ((uint32_t)f2bf(v[j][3] * rs) << 16);
        *(uint2*)(h + (size_t)t * DM + j * 256 + lane * 4) = w;
    }
}

template <class Epi, bool SPLITK>
__global__ __launch_bounds__(256) void naive_gemm(const bf16_t* __restrict__ A, int lda, const bf16_t* __restrict__ Bt, int ldb, int K, Epi epi, float* rowsq) {
    const int wave = threadIdx.x >> 6, lane = threadIdx.x & 63, r = lane & 31, hh = lane >> 5;
    const int m0 = blockIdx.y * 64 + (wave >> 1) * 32, n0 = blockIdx.x * 64 + (wave & 1) * 32;
    f32x16 acc, acc2;
#pragma unroll
    for (int i = 0; i < 16; ++i) { acc[i] = 0.f; acc2[i] = 0.f; }
    const bf16_t* ap = A + (size_t)(m0 + r) * lda + 8 * hh;
    const bf16_t* bp = Bt + (size_t)(n0 + r) * ldb + 8 * hh;
    const int K1 = SPLITK ? K / 2 : K;
    for (int k0 = 0; k0 < K1; k0 += 16) {
        const bf16x8 a = *(const bf16x8*)(ap + k0), b = *(const bf16x8*)(bp + k0);
        acc = __builtin_amdgcn_mfma_f32_32x32x16_bf16(a, b, acc, 0, 0, 0);
    }
    if (SPLITK) for (int k0 = K1; k0 < K; k0 += 16) {
        const bf16x8 a = *(const bf16x8*)(ap + k0), b = *(const bf16x8*)(bp + k0);
        acc2 = __builtin_amdgcn_mfma_f32_32x32x16_bf16(a, b, acc2, 0, 0, 0);
    }
#pragma unroll
    for (int reg = 0; reg < 16; ++reg) {
        const int row = m0 + (reg & 3) + 8 * (reg >> 2) + 4 * hh, col = n0 + r;
        float sq = epi(row, col, acc[reg], acc2[reg]);
        if (rowsq) {
#pragma unroll
            for (int o = 16; o >= 1; o >>= 1) sq += __shfl_xor(sq, o);
            if (r == 0) atomicAdd(rowsq + row, sq);
        }
    }
}

struct EpiInProj {
    bf16_t *Ugm, *SZ, *Q, *Kb, *Vt, *AZ;
    __device__ __forceinline__ float operator()(int m, int n, float v, float) const {
        if (n < 512) Ugm[((size_t)(n >> 4) * M_TOK + m) * 16 + (n & 15)] = f2bf(v);
        else if (n < 1024) SZ[(size_t)m * 512 + (n - 512)] = f2bf(silu_f(v));
        else if (n < 1536) Q[(size_t)m * 512 + (n - 1024)] = f2bf(v * 0.125f);
        else if (n < 1664) Kb[(size_t)m * 128 + (n - 1536)] = f2bf(v);
        else if (n < 1792) Vt[(size_t)(n - 1664) * M_TOK + m] = f2bf(v);
        else AZ[(size_t)m * 512 + (n - 1792)] = f2bf(silu_f(v));
        return 0.f;
    }
};
struct EpiGlu {
    const bf16_t *G, *SZ; const float* b_glu; bf16_t* MIX;
    __device__ __forceinline__ float operator()(int m, int n, float v, float) const {
        const float g = bf2f(G[(size_t)m * 512 + n]);
        const float val = g * sigmoid_f(v + b_glu[n]);
        MIX[(size_t)m * 1024 + n] = f2bf(val * bf2f(SZ[(size_t)m * 512 + n]));
        return val * val;
    }
};
struct EpiOut {
    const float *xp, *xs, *rsq1; float* out;
    __device__ __forceinline__ float operator()(int m, int n, float v1, float v2) const {
        const float x = (m < M_PROMPT) ? xp[(size_t)m * DM + n] : xs[(size_t)(m - M_PROMPT) * DM + n];
        const float rs = rsqrtf(rsq1[m] * (1.0f / 512.0f) + RMS_EPS);
        const float r = x + rs * v1 + v2;
        out[(size_t)m * DM + n] = r;
        return r * r;
    }
};

__global__ __launch_bounds__(64) void k_ssm_naive(int dir, const bf16_t* __restrict__ Ugm, const float* __restrict__ lam_re, const float* __restrict__ lam_im, const float* __restrict__ log_step,
                                                  const float* __restrict__ b_re, const float* __restrict__ b_im, const float* __restrict__ c_re, const float* __restrict__ c_im,
                                                  const float* __restrict__ d_skip, float* __restrict__ ytmp, bf16_t* __restrict__ G) {
    const int seq = blockIdx.x >> 5, g = blockIdx.x & 31, p = threadIdx.x;
    int start, len; if (seq < 32) { start = seq * 2048; len = 2048; } else { start = M_PROMPT + (seq - 32) * 4096; len = 4096; }
    const int pg = (dir * 32 + g);
    const float lr = lam_re[pg * 64 + p], li = lam_im[pg * 64 + p], dt = expf(log_step[pg]);
    const float mag = expf(lr * dt), are = mag * cosf(li * dt), aim = mag * sinf(li * dt);
    const float den = lr * lr + li * li, nr = are - 1.0f;
    const float cre = (nr * lr + aim * li) / den, cim = (aim * lr - nr * li) / den;
    float bbr[16], bbi[16], cr[16], ci[16], dsk = 0.f;
#pragma unroll
    for (int h = 0; h < 16; ++h) {
        const float br = b_re[(pg * 64 + p) * 16 + h], bi = b_im[(pg * 64 + p) * 16 + h];
        bbr[h] = cre * br - cim * bi; bbi[h] = cre * bi + cim * br;
        cr[h] = c_re[(pg * 16 + h) * 64 + p]; ci[h] = c_im[(pg * 16 + h) * 64 + p];
    }
    if (p < 16) dsk = d_skip[g * 16 + p];
    float sr = 0.f, si = 0.f;
    const bf16_t* up = Ugm + ((size_t)g * M_TOK + start) * 16;
    for (int i = 0; i < len; ++i) {
        const int t = dir ? (len - 1 - i) : i;
        const uint4 w0 = *(const uint4*)(up + (size_t)t * 16), w1 = *(const uint4*)(up + (size_t)t * 16 + 8);
        float u[16];
        u[0] = __uint_as_float(w0.x << 16); u[1] = __uint_as_float(w0.x & 0xffff0000u); u[2] = __uint_as_float(w0.y << 16); u[3] = __uint_as_float(w0.y & 0xffff0000u);
        u[4] = __uint_as_float(w0.z << 16); u[5] = __uint_as_float(w0.z & 0xffff0000u); u[6] = __uint_as_float(w0.w << 16); u[7] = __uint_as_float(w0.w & 0xffff0000u);
        u[8] = __uint_as_float(w1.x << 16); u[9] = __uint_as_float(w1.x & 0xffff0000u); u[10] = __uint_as_float(w1.y << 16); u[11] = __uint_as_float(w1.y & 0xffff0000u);
        u[12] = __uint_as_float(w1.z << 16); u[13] = __uint_as_float(w1.z & 0xffff0000u); u[14] = __uint_as_float(w1.w << 16); u[15] = __uint_as_float(w1.w & 0xffff0000u);
        float bur = 0.f, bui = 0.f;
#pragma unroll
        for (int h = 0; h < 16; ++h) { bur += u[h] * bbr[h]; bui += u[h] * bbi[h]; }
        const float nsr = are * sr - aim * si + bur, nsi = are * si + aim * sr + bui;
        sr = nsr; si = nsi;
        float mine = 0.f;
#pragma unroll
        for (int h = 0; h < 16; ++h) {
            float c = cr[h] * sr - ci[h] * si;
#pragma unroll
            for (int o = 32; o >= 1; o >>= 1) c += __shfl_xor(c, o);
            if (p == h) mine = c;
        }
        const size_t idx = (size_t)(start + t) * 512 + g * 16 + (p & 15);
        if (dir) { if (p < 16) ytmp[idx] = mine; }
        else {
            float uu = 0.f;
#pragma unroll
            for (int h = 0; h < 16; ++h) if (p == h) uu = u[h];
            if (p < 16) { const float y = dsk * uu + ytmp[idx] + mine; G[idx] = f2bf(gelu_tanh_f(y)); }
        }
    }
}

__device__ __forceinline__ int t5_bucket(int rel) {
    const int n = rel < 0 ? -rel : rel; int b = rel > 0 ? 16 : 0;
    if (n < 8) return b + n;
    const float nf = (float)n;
    int large = 8 + (int)(logf(nf / 8.0f) / 2.772588722239781f * 8.0f);
    if (large > 15) large = 15;
    return b + large;
}
__global__ __launch_bounds__(512) void k_attn_naive(const bf16_t* __restrict__ Q, const bf16_t* __restrict__ Kb, const bf16_t* __restrict__ Vt, const bf16_t* __restrict__ AZ,
                                                    const float* __restrict__ sink, const float* __restrict__ rel_bias, bf16_t* __restrict__ MIX) {
    __shared__ float qs[8][64];
    __shared__ float ps[8][320];
    __shared__ float ssq[8];
    const int t = blockIdx.x, hq = threadIdx.x >> 6, lane = threadIdx.x & 63, kvh = hq >> 2;
    int start, len; tok_seq(t, start, len);
    const int pos = t - start;
    qs[hq][lane] = bf2f(Q[(size_t)t * 512 + hq * 64 + lane]);
    __syncthreads();
    float sc[5]; float mx = sink[hq];
#pragma unroll
    for (int i = 0; i < 5; ++i) {
        const int rel = lane + 64 * i - 128; const int kp = pos + rel;
        float s = -1e30f;
        if (rel <= 128 && kp >= 0 && kp < len) {
            const bf16_t* kr = Kb + (size_t)(start + kp) * 128 + kvh * 64;
            float d = 0.f;
            for (int j = 0; j < 64; j += 8) {
                const uint4 w = *(const uint4*)(kr + j);
                d += qs[hq][j + 0] * __uint_as_float(w.x << 16) + qs[hq][j + 1] * __uint_as_float(w.x & 0xffff0000u)
                   + qs[hq][j + 2] * __uint_as_float(w.y << 16) + qs[hq][j + 3] * __uint_as_float(w.y & 0xffff0000u)
                   + qs[hq][j + 4] * __uint_as_float(w.z << 16) + qs[hq][j + 5] * __uint_as_float(w.z & 0xffff0000u)
                   + qs[hq][j + 6] * __uint_as_float(w.w << 16) + qs[hq][j + 7] * __uint_as_float(w.w & 0xffff0000u);
            }
            s = d + rel_bias[t5_bucket(rel) * 8 + hq];
        }
        sc[i] = s; mx = fmaxf(mx, s);
    }
#pragma unroll
    for (int o = 32; o >= 1; o >>= 1) mx = fmaxf(mx, __shfl_xor(mx, o));
    float sum = 0.f;
#pragma unroll
    for (int i = 0; i < 5; ++i) { const float pv = (sc[i] > -1e29f) ? __expf(sc[i] - mx) : 0.f; sc[i] = pv; sum += pv; }
#pragma unroll
    for (int o = 32; o >= 1; o >>= 1) sum += __shfl_xor(sum, o);
    sum += __expf(sink[hq] - mx);
    const float inv = 1.0f / sum;
#pragma unroll
    for (int i = 0; i < 5; ++i) ps[hq][lane + 64 * i] = sc[i] * inv;
    __syncthreads();
    float o = 0.f;
    const bf16_t* vr = Vt + (size_t)(kvh * 64 + lane) * M_TOK + start;
    for (int j = 0; j < 257; ++j) {
        const int kp = pos + j - 128;
        if (kp >= 0 && kp < len) o += ps[hq][j] * bf2f(vr[kp]);
    }
    float sq = o * o;
#pragma unroll
    for (int of = 32; of >= 1; of >>= 1) sq += __shfl_xor(sq, of);
    if (lane == 0) ssq[hq] = sq;
    __syncthreads();
    float tot = 0.f;
#pragma unroll
    for (int i = 0; i < 8; ++i) tot += ssq[i];
    const float rs = rsqrtf(tot * (1.0f / 512.0f) + RMS_EPS);
    MIX[(size_t)t * 1024 + 512 + hq * 64 + lane] = f2bf(o * rs * bf2f(AZ[(size_t)t * 512 + hq * 64 + lane]));
}

__global__ __launch_bounds__(256) void k_final(float* __restrict__ out, const float* __restrict__ rsq2, const float* __restrict__ fw) {
    const int t = blockIdx.x, c = threadIdx.x * 4;
    const float rs = rsqrtf(rsq2[t] * (1.0f / DM) + RMS_EPS);
    f32x4 v = *(f32x4*)(out + (size_t)t * DM + c); const f32x4 w = *(const f32x4*)(fw + c);
    v[0] *= rs * w[0]; v[1] *= rs * w[1]; v[2] *= rs * w[2]; v[3] *= rs * w[3];
    *(f32x4*)(out + (size_t)t * DM + c) = v;
}

extern "C" void kernel_launch(void* const* d_in, const int* in_sizes, int n_in, void* d_out, int out_size, void* d_ws, size_t ws_size, hipStream_t stream) {
    (void)in_sizes; (void)n_in; (void)out_size;
    if (ws_size < OFF_END) { fprintf(stderr, "workspace too small: %zu < %zu\n", ws_size, (size_t)OFF_END); return; }
    const float* x_prompt = (const float*)d_in[0]; const float* x_sample = (const float*)d_in[1];
    const float* norm_w = (const float*)d_in[2]; const float* w_in = (const float*)d_in[3];
    const float* lam_re = (const float*)d_in[4]; const float* lam_im = (const float*)d_in[5]; const float* log_step = (const float*)d_in[6];
    const float* b_re = (const float*)d_in[7]; const float* b_im = (const float*)d_in[8]; const float* c_re = (const float*)d_in[9]; const float* c_im = (const float*)d_in[10];
    const float* d_skip = (const float*)d_in[11]; const float* w_glu = (const float*)d_in[12]; const float* b_glu = (const float*)d_in[13];
    const float* ssm_norm_w = (const float*)d_in[14]; const float* sink = (const float*)d_in[15]; const float* attn_norm_w = (const float*)d_in[16];
    const float* w_out = (const float*)d_in[17]; const float* rel_bias = (const float*)d_in[18]; const float* final_norm_w = (const float*)d_in[19];
    char* ws = (char*)d_ws; float* out = (float*)d_out;
    bf16_t* H = (bf16_t*)(ws + OFF_A); bf16_t* MIX = (bf16_t*)(ws + OFF_A); float* ytmp = (float*)(ws + OFF_A);
    bf16_t* Ugm = (bf16_t*)(ws + OFF_UGM); bf16_t* SZ = (bf16_t*)(ws + OFF_SZ); bf16_t* Q = (bf16_t*)(ws + OFF_Q); bf16_t* Kb = (bf16_t*)(ws + OFF_KB);
    bf16_t* Vt = (bf16_t*)(ws + OFF_VT); bf16_t* AZ = (bf16_t*)(ws + OFF_AZ); bf16_t* G = (bf16_t*)(ws + OFF_G);
    bf16_t* WinT = (bf16_t*)(ws + OFF_WIN); bf16_t* WgluT = (bf16_t*)(ws + OFF_WGLU); bf16_t* WoutT = (bf16_t*)(ws + OFF_WOUT);
    float* rsq1 = (float*)(ws + OFF_RSQ1); float* rsq2 = (float*)(ws + OFF_RSQ2);

    hipMemsetAsync(rsq1, 0, 2 * 512 * 1024, stream);
    prep_wT<<<dim3(NPROJ / 32, DM / 32), 256, 0, stream>>>(w_in, DM, NPROJ, norm_w, norm_w, DM, WinT);
    prep_wT<<<dim3(512 / 32, 512 / 32), 256, 0, stream>>>(w_glu, 512, 512, nullptr, nullptr, 0, WgluT);
    prep_wT<<<dim3(DM / 32, DM / 32), 256, 0, stream>>>(w_out, DM, DM, ssm_norm_w, attn_norm_w, 512, WoutT);
    k_rmsnorm_in<<<M_TOK / 4, 256, 0, stream>>>(x_prompt, x_sample, H);
    { EpiInProj e{Ugm, SZ, Q, Kb, Vt, AZ};
      naive_gemm<EpiInProj, false><<<dim3(NPROJ / 64, M_TOK / 64), 256, 0, stream>>>(H, DM, WinT, DM, DM, e, nullptr); }
    k_ssm_naive<<<48 * 32, 64, 0, stream>>>(1, Ugm, lam_re, lam_im, log_step, b_re, b_im, c_re, c_im, d_skip, ytmp, G);
    k_ssm_naive<<<48 * 32, 64, 0, stream>>>(0, Ugm, lam_re, lam_im, log_step, b_re, b_im, c_re, c_im, d_skip, ytmp, G);
    k_attn_naive<<<M_TOK, 512, 0, stream>>>(Q, Kb, Vt, AZ, sink, rel_bias, MIX);
    { EpiGlu e{G, SZ, b_glu, MIX};
      naive_gemm<EpiGlu, false><<<dim3(512 / 64, M_TOK / 64), 256, 0, stream>>>(G, 512, WgluT, 512, 512, e, rsq1); }
    { EpiOut e{x_prompt, x_sample, rsq1, out};
      naive_gemm<EpiOut, true><<<dim3(DM / 64, M_TOK / 64), 256, 0, stream>>>(MIX, DM, WoutT, DM, DM, e, rsq2); }
    k_final<<<M_TOK, 256, 0, stream>>>(out, rsq2, final_norm_w);
}
```

```cpp
#include <hip/hip_runtime.h>
#include <hip/hip_cooperative_groups.h>
#include <stdint.h>
#include <stdio.h>
namespace cg = cooperative_groups;

typedef unsigned short bf16_t;
typedef short bf16x8 __attribute__((ext_vector_type(8)));
typedef float f32x16 __attribute__((ext_vector_type(16)));
typedef float f32x4 __attribute__((ext_vector_type(4)));
typedef unsigned u32x4 __attribute__((ext_vector_type(4)));
#define LAS __attribute__((address_space(3)))

constexpr int M_TOK = 131072;
constexpr int M_PROMPT = 65536;
constexpr int DM = 1024;
constexpr int NPROJ = 2304;
constexpr float RMS_EPS = 1e-6f;

__device__ __forceinline__ bf16_t f2bf(float f) { uint32_t u = __float_as_uint(f); u += 0x7fffu + ((u >> 16) & 1u); return (bf16_t)(u >> 16); }
__device__ __forceinline__ float bf2f(bf16_t b) { return __uint_as_float(((uint32_t)b) << 16); }
__device__ __forceinline__ float bflo(unsigned w) { return __uint_as_float(w << 16); }
__device__ __forceinline__ float bfhi(unsigned w) { return __uint_as_float(w & 0xffff0000u); }
__device__ __forceinline__ unsigned cvt_pk_bf16(float lo, float hi) { unsigned r; asm volatile("v_cvt_pk_bf16_f32 %0, %1, %2" : "=v"(r) : "v"(lo), "v"(hi)); return r; }
__device__ __forceinline__ float silu_f(float v) { return v / (1.0f + __expf(-v)); }
__device__ __forceinline__ float sigmoid_f(float v) { return 1.0f / (1.0f + __expf(-v)); }
__device__ __forceinline__ float gelu_tanh_f(float x) { const float u = 0.7978845608028654f * (x + 0.044715f * x * x * x); return 0.5f * x * (1.0f + tanhf(u)); }
__device__ __forceinline__ void tok_seq(int t, int& start, int& len) {
    if (t < M_PROMPT) { len = 2048; start = t & ~2047; } else { len = 4096; start = M_PROMPT + ((t - M_PROMPT) & ~4095); }
}

constexpr size_t MiB = 1024 * 1024;
constexpr size_t OFF_A    = 0;
constexpr size_t OFF_UGM  = 256 * MiB;
constexpr size_t OFF_SZ   = OFF_UGM + 128 * MiB;
constexpr size_t OFF_Q    = OFF_SZ + 128 * MiB;
constexpr size_t OFF_KB   = OFF_Q + 128 * MiB;
constexpr size_t OFF_VT   = OFF_KB + 32 * MiB;
constexpr size_t OFF_AZ   = OFF_VT + 32 * MiB;
constexpr size_t OFF_G    = OFF_AZ + 128 * MiB;
constexpr size_t OFF_WIN  = OFF_G + 128 * MiB;
constexpr size_t OFF_WGLU = OFF_WIN + 5 * MiB;
constexpr size_t OFF_WOUT = OFF_WGLU + 1 * MiB;
constexpr size_t OFF_RSQ1 = OFF_WOUT + 2 * MiB;
constexpr size_t OFF_RSQ2 = OFF_RSQ1 + 512 * 1024;
constexpr size_t OFF_END  = OFF_RSQ2 + 512 * 1024;

namespace pg8 {
#define PG8_LAS __attribute__((address_space(3)))
typedef unsigned short bf16_t;
typedef short bf16x8 __attribute__((ext_vector_type(8)));
typedef float f32x4 __attribute__((ext_vector_type(4)));
typedef unsigned u32x4 __attribute__((ext_vector_type(4)));
constexpr int BM = 256, BK = 64, HALF = 128, HTB = HALF * BK * 2  , STAGE_BYTES = 8 * HTB, NXCD = 8, WGM = 8;

__host__ __device__ __forceinline__ int lds_byte(int r, int c) { const int st = (r >> 4) * 2 + (c >> 5), rr = r & 15, cc = c & 31, ob = rr * 64 + cc * 2; return st * 1024 + (ob ^ (((ob >> 9) & 1) << 5)); }
__host__ __device__ __forceinline__ void stage_rc(int b, int& R, int& C) { const int st = b / 1024, sb = b % 1024, swz = sb ^ (((sb >> 9) & 1) << 5); R = (st >> 1) * 16 + swz / 64; C = (st & 1) * 32 + (swz % 64) / 2; }
__host__ __device__ __forceinline__ int perm32(int rho) { const int n = rho >> 4, i = rho & 15; return 8 * (i >> 2) + 4 * n + (i & 3); }

struct Unit { int pm, pn; };
struct Gemm { const bf16_t* A; const bf16_t* Bt; int M, N, K; };

struct StaticOrder {
    int nM, nN, nwg, G, c;
    __host__ __device__ void init(int M, int N, int G_, int c_) { nM = M / BM; nN = N / BM; nwg = nM * nN; G = G_; c = c_; }
    __host__ __device__ bool next(int i, Unit& u) const {
        const long L = (long)i * G + c; if (L >= nwg) return false;
        int wgid = (int)L; { const int q = nwg / NXCD, r = nwg % NXCD, xcd = wgid % NXCD, off = wgid / NXCD; wgid = (xcd < r ? xcd * (q + 1) : r * (q + 1) + (xcd - r) * q) + off; }
        const int nig = WGM * nN, gid = wgid / nig, fm = gid * WGM, gsz = (nM - fm) < WGM ? (nM - fm) : WGM;
        u.pm = fm + ((wgid % nig) % gsz); u.pn = (wgid % nig) / gsz; return true;
    }
    __device__ __forceinline__ void a_ready(const Unit&) const {}
    __device__ __forceinline__ void done(const Unit&) const {}
};


__device__ __forceinline__ u32x4 pack8(const f32x4 a, const f32x4 b) { u32x4 w; w.x = ::cvt_pk_bf16(a[0], a[1]); w.y = ::cvt_pk_bf16(a[2], a[3]); w.z = ::cvt_pk_bf16(b[0], b[1]); w.w = ::cvt_pk_bf16(b[2], b[3]); return w; }
__device__ __forceinline__ f32x4 silu4(const f32x4 v) { f32x4 r; r[0] = ::silu_f(v[0]); r[1] = ::silu_f(v[1]); r[2] = ::silu_f(v[2]); r[3] = ::silu_f(v[3]); return r; }

struct EpiIn {
    static constexpr bool PERM = true, AFTER_DRAIN = false, MIDK = false;
    bf16_t *Ugm, *SZ, *Q, *Kb, *Vt, *AZ;
    __device__ __forceinline__ void operator()(const f32x4 (&acc)[2][2][4][2], const Unit& u, int wr, int wc, int fr, int fq) const {
        asm volatile("" : "+v"(fr), "+v"(fq));
        const int row0 = u.pm * BM + wr * 64 + fr, cl = wc * 32 + 8 * fq, pn = u.pn;
#pragma unroll
        for (int ai = 0; ai < 2; ++ai)
#pragma unroll
            for (int m = 0; m < 4; ++m) {
                const size_t row = (size_t)(row0 + ai * HALF + m * 16);
#pragma unroll
                for (int bj = 0; bj < 2; ++bj) {
                    const f32x4 v0 = acc[ai][bj][m][0], v1 = acc[ai][bj][m][1];
                    const int c = pn * BM + bj * HALF + cl;
                    if (pn < 2) { *(u32x4*)(Ugm + ((size_t)(c >> 4) * M_TOK + row) * 16 + (c & 15)) = pack8(v0, v1); }
                    else if (pn < 4) { *(u32x4*)(SZ + row * 512 + (c - 512)) = pack8(silu4(v0), silu4(v1)); }
                    else if (pn < 6) { *(u32x4*)(Q + row * 512 + (c - 1024)) = pack8(v0 * 0.125f, v1 * 0.125f); }
                    else if (pn == 6) {
                        if (bj == 0) { *(u32x4*)(Kb + row * 128 + cl) = pack8(v0, v1); }
                        else {
                            bf16_t* vp = Vt + (size_t)cl * M_TOK + row;
#pragma unroll
                            for (int j = 0; j < 4; ++j) { vp[(size_t)j * M_TOK] = ::f2bf(v0[j]); vp[(size_t)(j + 4) * M_TOK] = ::f2bf(v1[j]); }
                        }
                    }
                    else { *(u32x4*)(AZ + row * 512 + (c - 1792)) = pack8(silu4(v0), silu4(v1)); }
                }
            }
    }
};

struct EpiGlu {
    static constexpr bool PERM = true, AFTER_DRAIN = false, MIDK = false;
    const bf16_t *G, *SZ; const float* b_glu; bf16_t* MIX; float* rsq1;
    __device__ __forceinline__ void operator()(const f32x4 (&acc)[2][2][4][2], const Unit& u, int wr, int wc, int fr, int fq) const {
        asm volatile("" : "+v"(fr), "+v"(fq));
        const int row0 = u.pm * BM + wr * 64 + fr, cl = wc * 32 + 8 * fq, pn = u.pn;
        f32x4 bv[2][2];
#pragma unroll
        for (int bj = 0; bj < 2; ++bj) { bv[bj][0] = *(const f32x4*)(b_glu + pn * BM + bj * HALF + cl); bv[bj][1] = *(const f32x4*)(b_glu + pn * BM + bj * HALF + cl + 4); }
#pragma unroll
        for (int ai = 0; ai < 2; ++ai)
#pragma unroll
            for (int m = 0; m < 4; ++m) {
                const size_t row = (size_t)(row0 + ai * HALF + m * 16);
                float sq = 0.f;
#pragma unroll
                for (int bj = 0; bj < 2; ++bj) {
                    const int c = pn * BM + bj * HALF + cl;
                    const u32x4 gw = *(const u32x4*)(G + row * 512 + c), zw = *(const u32x4*)(SZ + row * 512 + c);
                    const f32x4 a0 = acc[ai][bj][m][0] + bv[bj][0], a1 = acc[ai][bj][m][1] + bv[bj][1];
                    f32x4 g0, g1, z0, z1;
                    g0[0] = ::bflo(gw.x); g0[1] = ::bfhi(gw.x); g0[2] = ::bflo(gw.y); g0[3] = ::bfhi(gw.y); g1[0] = ::bflo(gw.z); g1[1] = ::bfhi(gw.z); g1[2] = ::bflo(gw.w); g1[3] = ::bfhi(gw.w);
                    z0[0] = ::bflo(zw.x); z0[1] = ::bfhi(zw.x); z0[2] = ::bflo(zw.y); z0[3] = ::bfhi(zw.y); z1[0] = ::bflo(zw.z); z1[1] = ::bfhi(zw.z); z1[2] = ::bflo(zw.w); z1[3] = ::bfhi(zw.w);
                    f32x4 v0, v1;
#pragma unroll
                    for (int j = 0; j < 4; ++j) { v0[j] = g0[j] * ::sigmoid_f(a0[j]); v1[j] = g1[j] * ::sigmoid_f(a1[j]); sq += v0[j] * v0[j] + v1[j] * v1[j]; }
                    *(u32x4*)(MIX + row * 1024 + c) = pack8(v0 * z0, v1 * z1);
                }
                sq += __shfl_xor(sq, 16); sq += __shfl_xor(sq, 32);
                if (fq == 0) atomicAdd(rsq1 + row, sq);
                if (m & 1) asm volatile("" ::: "memory");
            }
    }
};

struct EpiOut {
    static constexpr bool PERM = false, AFTER_DRAIN = false, MIDK = true;
    const float *xp, *xs; float* out; const float* rsq1; float* rsq2;
    __device__ __forceinline__ void mid(f32x4 (&acc)[2][2][4][2], const Unit& u, int wr, int wc, int fr, int fq) const {
        asm volatile("" : "+v"(fr));
#pragma unroll
        for (int ai = 0; ai < 2; ++ai)
#pragma unroll
            for (int m = 0; m < 4; ++m) {
                const int row = u.pm * BM + ai * HALF + wr * 64 + m * 16 + fr;
                const float rs = rsqrtf(rsq1[row] * (1.0f / 512.0f) + ::RMS_EPS);
#pragma unroll
                for (int bj = 0; bj < 2; ++bj)
#pragma unroll
                    for (int n = 0; n < 2; ++n) acc[ai][bj][m][n] = acc[ai][bj][m][n] * rs;
            }
    }
    __device__ __forceinline__ void operator()(const f32x4 (&acc)[2][2][4][2], const Unit& u, int wr, int wc, int fr, int fq) const {
        asm volatile("" : "+v"(fr), "+v"(fq));
        const int col0 = u.pn * BM + wc * 32 + 4 * fq, r0 = u.pm * BM;
        const float* xb = (r0 < ::M_PROMPT) ? xp + (size_t)r0 * 1024 : xs + (size_t)(r0 - ::M_PROMPT) * 1024;
        float* ob = out + (size_t)r0 * 1024;
#pragma unroll
        for (int ai = 0; ai < 2; ++ai)
#pragma unroll
            for (int m = 0; m < 4; ++m) {
                const int rl = ai * HALF + wr * 64 + m * 16 + fr;
                float sq = 0.f;
#pragma unroll
                for (int bj = 0; bj < 2; ++bj)
#pragma unroll
                    for (int n = 0; n < 2; ++n) {
                        const size_t off = (size_t)rl * 1024 + col0 + bj * HALF + n * 16;
                        const f32x4 r = *(const f32x4*)(xb + off) + acc[ai][bj][m][n];
                        *(f32x4*)(ob + off) = r;
                        sq += (r[0] * r[0] + r[1] * r[1]) + (r[2] * r[2] + r[3] * r[3]);
                    }
                sq += __shfl_xor(sq, 16); sq += __shfl_xor(sq, 32);
                if (fq == 0) atomicAdd(rsq2 + r0 + rl, sq);
                if (m & 1) asm volatile("" ::: "memory");
            }
    }
};

template <class Epi, class Sched, bool ALIGN_EPI = false, bool SP2 = false>
__device__ __forceinline__ void gemm_phase(PG8_LAS unsigned char* lds, const Gemm g, const Sched& S, const Epi& E) {
    const int tid = threadIdx.x, wid = __builtin_amdgcn_readfirstlane(tid >> 6), lane = tid & 63, wr = wid >> 2, wc = wid & 3, fr = lane & 15, fq = lane >> 4;
    const int K = g.K, nt = K / BK;
    unsigned voffA[2], voffB[2];
#pragma unroll
    for (int i = 0; i < 2; ++i) { int R, C; stage_rc(tid * 16 + i * 8192, R, C); const int Rb = Epi::PERM ? ((R & ~31) + perm32(R & 31)) : R;
        voffA[i] = (unsigned)(R * K + C) * 2u; voffB[i] = (unsigned)(Rb * K + C) * 2u; }
    const size_t kstep = (size_t)(BK * 2);
    const size_t hstep = (size_t)HALF * K * 2;
    const size_t tstep = 2 * hstep;
    const unsigned ldsw = (unsigned)wid * 1024u;
    const int aoff = lds_byte(wr * 64 + fr, fq * 8), boff = lds_byte(wc * 32 + fr, fq * 8);
#define PG8_SA(b, h) (((b) * 2 + (h)) * HTB)
#define PG8_SB(b, h) ((4 + (b) * 2 + (h)) * HTB)
#define PG8_STAGE(bufoff, gbase, voff) do { _Pragma("unroll") for (int _i = 0; _i < 2; ++_i) \
        __builtin_amdgcn_global_load_lds((const unsigned*)((const char*)(gbase) + (voff)[_i]), (PG8_LAS unsigned*)(lds + (bufoff) + ldsw + _i * 8192), 16, 0, 0); } while (0)
#define PG8_LDA(dst, b, h) do { _Pragma("unroll") for (int m = 0; m < 4; ++m) _Pragma("unroll") for (int k = 0; k < 2; ++k) dst[m][k] = *(const PG8_LAS bf16x8*)(lds + PG8_SA(b, h) + aoff + m * 2048 + k * 1024); } while (0)
#define PG8_LDB(dst, b, h) do { _Pragma("unroll") for (int n = 0; n < 2; ++n) _Pragma("unroll") for (int k = 0; k < 2; ++k) dst[n][k] = *(const PG8_LAS bf16x8*)(lds + PG8_SB(b, h) + boff + n * 2048 + k * 1024); } while (0)
#define PG8_MMA(ai, bj, At, Bt) do { __builtin_amdgcn_s_setprio(1); _Pragma("unroll") for (int m = 0; m < 4; ++m) _Pragma("unroll") for (int n = 0; n < 2; ++n) _Pragma("unroll") for (int k = 0; k < 2; ++k) \
        acc[ai][bj][m][n] = __builtin_amdgcn_mfma_f32_16x16x32_bf16(Bt[n][k], At[m][k], acc[ai][bj][m][n], 0, 0, 0); __builtin_amdgcn_s_setprio(0); } while (0)
#define PG8_WAIT_V(n) asm volatile("s_waitcnt vmcnt(" #n ")" ::: "memory")
#define PG8_WAIT_L(n) asm volatile("s_waitcnt lgkmcnt(" #n ")" ::: "memory")
#define PG8_BAR __builtin_amdgcn_s_barrier()
#define PG8_SCHED __builtin_amdgcn_sched_barrier(0)
    Unit cur, nxt; int ui = 0;
    if (!S.next(0, cur)) return;
    f32x4 acc[2][2][4][2];
#pragma unroll
    for (int a = 0; a < 2; ++a)
#pragma unroll
        for (int b = 0; b < 2; ++b)
#pragma unroll
            for (int m = 0; m < 4; ++m)
#pragma unroll
                for (int n = 0; n < 2; ++n) acc[a][b][m][n] = (f32x4){0.f, 0.f, 0.f, 0.f};
    bf16x8 At[4][2], B0[2][2], B1[2][2];
    const char* cA = (const char*)g.A + (size_t)cur.pm * tstep; const char* cB = (const char*)g.Bt + (size_t)cur.pn * tstep;
    S.a_ready(cur);
    if constexpr (SP2) {
        PG8_STAGE(PG8_SB(0, 0), cB, voffB); PG8_STAGE(PG8_SB(0, 1), cB + hstep, voffB); PG8_STAGE(PG8_SA(0, 0), cA, voffA); PG8_STAGE(PG8_SA(0, 1), cA + hstep, voffA);
        if (wr == 1) PG8_BAR;
        PG8_WAIT_V(2); PG8_BAR;
        PG8_STAGE(PG8_SB(1, 0), cB + kstep, voffB); PG8_STAGE(PG8_SA(1, 0), cA + kstep, voffA); PG8_STAGE(PG8_SB(1, 1), cB + hstep + kstep, voffB);
        PG8_WAIT_V(6); PG8_BAR;
    } else {
        PG8_STAGE(PG8_SB(0, 0), cB, voffB); PG8_STAGE(PG8_SA(0, 0), cA, voffA); PG8_STAGE(PG8_SB(0, 1), cB + hstep, voffB); PG8_STAGE(PG8_SA(0, 1), cA + hstep, voffA);
        if (wr == 1) PG8_BAR;
        PG8_WAIT_V(4); PG8_BAR;
        PG8_STAGE(PG8_SB(1, 0), cB + kstep, voffB); PG8_STAGE(PG8_SA(1, 0), cA + kstep, voffA); PG8_STAGE(PG8_SB(1, 1), cB + hstep + kstep, voffB);
        PG8_WAIT_V(6); PG8_BAR;
    }
    for (;;) {
        const bool has_next = S.next(ui + 1, nxt);
        const char* nA = has_next ? (const char*)g.A + (size_t)nxt.pm * tstep : cA; const char* nB = has_next ? (const char*)g.Bt + (size_t)nxt.pn * tstep : cB;
        for (int t = 0; t < nt; t += 2) {
            if constexpr (Epi::MIDK) { if (t == (nt >> 1)) E.mid(acc, cur, wr, wc, fr, fq); }
            const bool last = (t == nt - 2);
            const char* a1 = cA + (size_t)(t + 1) * kstep;
            const char* a2 = last ? nA : cA + (size_t)(t + 2) * kstep; const char* b2 = last ? nB : cB + (size_t)(t + 2) * kstep;
            const char* a3 = a2 + kstep; const char* b3 = b2 + kstep;
            if (last && has_next) S.a_ready(nxt);
            if constexpr (SP2) {
            PG8_LDB(B0, 0, 0); PG8_LDB(B1, 0, 1); PG8_SCHED; PG8_LDA(At, 0, 0); PG8_STAGE(PG8_SA(1, 1), a1 + hstep, voffA);
            PG8_WAIT_V(8); PG8_WAIT_L(0); PG8_BAR; PG8_MMA(0, 0, At, B0); PG8_MMA(0, 1, At, B1); PG8_BAR; PG8_SCHED;
            PG8_LDA(At, 0, 1); PG8_STAGE(PG8_SB(0, 0), b2, voffB); PG8_STAGE(PG8_SB(0, 1), b2 + hstep, voffB); PG8_STAGE(PG8_SA(0, 0), a2, voffA);
            PG8_WAIT_V(8); PG8_WAIT_L(0); PG8_BAR; PG8_MMA(1, 0, At, B0); PG8_MMA(1, 1, At, B1); PG8_BAR; PG8_SCHED;
            PG8_LDB(B0, 1, 0); PG8_LDB(B1, 1, 1); PG8_SCHED; PG8_LDA(At, 1, 0); PG8_STAGE(PG8_SA(0, 1), a2 + hstep, voffA);
            PG8_WAIT_V(8); PG8_WAIT_L(0); PG8_BAR; PG8_MMA(0, 0, At, B0); PG8_MMA(0, 1, At, B1); PG8_BAR; PG8_SCHED;
            PG8_LDA(At, 1, 1); PG8_STAGE(PG8_SB(1, 0), b3, voffB); PG8_STAGE(PG8_SB(1, 1), b3 + hstep, voffB); PG8_STAGE(PG8_SA(1, 0), a3, voffA);
            PG8_WAIT_V(8); PG8_WAIT_L(0); PG8_BAR; PG8_MMA(1, 0, At, B0); PG8_MMA(1, 1, At, B1); PG8_BAR; PG8_SCHED;
            } else {
            PG8_LDB(B0, 0, 0); PG8_SCHED; PG8_LDA(At, 0, 0); PG8_STAGE(PG8_SA(1, 1), a1 + hstep, voffA);
            PG8_WAIT_L(8); PG8_BAR; PG8_WAIT_L(0); PG8_MMA(0, 0, At, B0); PG8_BAR; PG8_SCHED;
            PG8_LDB(B1, 0, 1); PG8_STAGE(PG8_SB(0, 0), b2, voffB);
            PG8_BAR; PG8_WAIT_L(0); PG8_MMA(0, 1, At, B1); PG8_BAR;
            PG8_LDA(At, 0, 1); PG8_STAGE(PG8_SA(0, 0), a2, voffA);
            PG8_BAR; PG8_WAIT_L(0); PG8_MMA(1, 0, At, B0); PG8_BAR; PG8_SCHED;
            PG8_STAGE(PG8_SB(0, 1), b2 + hstep, voffB);
            PG8_WAIT_V(6); PG8_BAR; PG8_MMA(1, 1, At, B1); PG8_BAR;
            PG8_LDB(B0, 1, 0); PG8_SCHED; PG8_LDA(At, 1, 0); PG8_STAGE(PG8_SA(0, 1), a2 + hstep, voffA);
            PG8_WAIT_L(8); PG8_BAR; PG8_WAIT_L(0); PG8_MMA(0, 0, At, B0); PG8_BAR; PG8_SCHED;
            PG8_LDB(B1, 1, 1); PG8_STAGE(PG8_SB(1, 0), b3, voffB);
            PG8_BAR; PG8_WAIT_L(0); PG8_MMA(0, 1, At, B1); PG8_BAR;
            PG8_LDA(At, 1, 1); PG8_STAGE(PG8_SA(1, 0), a3, voffA);
            PG8_BAR; PG8_WAIT_L(0); PG8_MMA(1, 0, At, B0); PG8_BAR; PG8_SCHED;
            PG8_STAGE(PG8_SB(1, 1), b3 + hstep, voffB);
            PG8_WAIT_V(6); PG8_BAR; PG8_MMA(1, 1, At, B1); PG8_BAR;
            }
        }
        if constexpr (ALIGN_EPI) { if (wr == 0) PG8_BAR; }
        if constexpr (!Epi::AFTER_DRAIN) { E(acc, cur, wr, wc, fr, fq); S.done(cur); }
        if (!has_next) break;
#pragma unroll
        for (int a = 0; a < 2; ++a)
#pragma unroll
            for (int b = 0; b < 2; ++b)
#pragma unroll
                for (int m = 0; m < 4; ++m)
#pragma unroll
                    for (int n = 0; n < 2; ++n) acc[a][b][m][n] = (f32x4){0.f, 0.f, 0.f, 0.f};
        cur = nxt; cA = nA; cB = nB; ++ui;
        if constexpr (ALIGN_EPI) { if (wr == 1) PG8_BAR; }
    }
    PG8_WAIT_V(0);
    if constexpr (!ALIGN_EPI) { if (wr == 0) PG8_BAR; }
    PG8_BAR;
    if constexpr (Epi::AFTER_DRAIN) { E.fused(acc, cur, wr, wc, fr, fq, lds, wid, lane); S.done(cur); }
#undef PG8_SA
#undef PG8_SB
#undef PG8_STAGE
#undef PG8_LDA
#undef PG8_LDB
#undef PG8_MMA
#undef PG8_WAIT_V
#undef PG8_WAIT_L
#undef PG8_BAR
#undef PG8_SCHED
}
}

struct Args {
    const float* in[20];
    float* out; unsigned char* ws;
};
typedef const unsigned char __attribute__((address_space(4)))* kptr_t;
struct KA {
    kptr_t p;
    __device__ __forceinline__ KA() { p = (kptr_t)__builtin_amdgcn_kernarg_segment_ptr(); asm volatile("" : "+s"(p)); }
    __device__ __forceinline__ const float* in(int i) const { return *(const float* const __attribute__((address_space(4)))*)(p + 8 * i); }
    __device__ __forceinline__ float* out() const { return *(float* const __attribute__((address_space(4)))*)(p + 160); }
    __device__ __forceinline__ unsigned char* ws() const { return *(unsigned char* const __attribute__((address_space(4)))*)(p + 168); }
};

__device__ __forceinline__ float wave_sum(float v) {
#pragma unroll
    for (int o = 1; o < 64; o <<= 1) v += __shfl_xor(v, o);
    return v;
}

__device__ __forceinline__ void p0_transpose_item(const float* __restrict__ w, int K, int N, const float* __restrict__ s1, const float* __restrict__ s2, int ksplit, bf16_t* __restrict__ out,
                                                  LAS float* scr, int item, int lane) {
    const int nblk = N / 32, kb = item / nblk, nb = item % nblk, k0 = 32 * kb, n0 = 32 * nb;
#pragma unroll 4
    for (int i = 0; i < 16; ++i) {
        const int kk = 2 * i + (lane >> 5), k = k0 + kk; float sc = 1.0f;
        if (s1) sc = (k < ksplit) ? s1[k] : s2[k - ksplit];
        scr[kk * 33 + (lane & 31)] = w[(size_t)k * N + n0 + (lane & 31)] * sc;
    }
    asm volatile("s_waitcnt lgkmcnt(0)" ::: "memory");
#pragma unroll 4
    for (int j = 0; j < 16; ++j) { const int n = 2 * j + (lane >> 5), k = lane & 31; out[(size_t)(n0 + n) * K + k0 + k] = f2bf(scr[k * 33 + n]); }
    asm volatile("s_waitcnt lgkmcnt(0)" ::: "memory");
}

__device__ __forceinline__ void p0_prologue(LAS unsigned char* lds, int wave, int lane, int G) {
    const KA a; unsigned char* ws = a.ws();
    LAS float* scr = (LAS float*)(lds + wave * 4352);
    const int gw = blockIdx.x * 8 + wave, NGW = G * 8;
    constexpr int I_IN = (DM / 32) * (NPROJ / 32), I_GLU = 16 * 16, I_OUT = 32 * 32;
    for (int it = gw; it < I_IN + I_GLU + I_OUT; it += NGW) {
        int r = it;
        if (r < I_IN) { p0_transpose_item(a.in(3), DM, NPROJ, a.in(2), a.in(2), DM, (bf16_t*)(ws + OFF_WIN), scr, r, lane); continue; } r -= I_IN;
        if (r < I_GLU) { p0_transpose_item(a.in(12), 512, 512, nullptr, nullptr, 0, (bf16_t*)(ws + OFF_WGLU), scr, r, lane); continue; } r -= I_GLU;
        p0_transpose_item(a.in(17), DM, DM, a.in(14), a.in(16), 512, (bf16_t*)(ws + OFF_WOUT), scr, r, lane);
    }
    bf16_t* H = (bf16_t*)(ws + OFF_A);
    for (int t = gw; t < M_TOK; t += NGW) {
        const float* x = (t < M_PROMPT) ? a.in(0) + (size_t)t * DM : a.in(1) + (size_t)(t - M_PROMPT) * DM;
        f32x4 v[4]; float s = 0.f;
#pragma unroll
        for (int j = 0; j < 4; ++j) { v[j] = *(const f32x4*)(x + j * 256 + lane * 4); s += (v[j][0] * v[j][0] + v[j][1] * v[j][1]) + (v[j][2] * v[j][2] + v[j][3] * v[j][3]); }
        const float rs = rsqrtf(wave_sum(s) * (1.0f / DM) + RMS_EPS);
#pragma unroll
        for (int j = 0; j < 4; ++j) { uint2 w; w.x = cvt_pk_bf16(v[j][0] * rs, v[j][1] * rs); w.y = cvt_pk_bf16(v[j][2] * rs, v[j][3] * rs); *(uint2*)(H + (size_t)t * DM + j * 256 + lane * 4) = w; }
    }
    float* rsq = (float*)(ws + OFF_RSQ1);
    for (int i = blockIdx.x * 512 + threadIdx.x; i < 2 * M_TOK; i += G * 512) rsq[i] = 0.f;
}

__device__ __forceinline__ void ssm_naive_item(int dir, int seq, int g, int p, const bf16_t* __restrict__ Ugm, const float* __restrict__ lam_re, const float* __restrict__ lam_im, const float* __restrict__ log_step,
                                               const float* __restrict__ b_re, const float* __restrict__ b_im, const float* __restrict__ c_re, const float* __restrict__ c_im,
                                               const float* __restrict__ d_skip, float* __restrict__ ytmp, bf16_t* __restrict__ G) {
    int start, len; if (seq < 32) { start = seq * 2048; len = 2048; } else { start = M_PROMPT + (seq - 32) * 4096; len = 4096; }
    const int pg = (dir * 32 + g);
    const float lr = lam_re[pg * 64 + p], li = lam_im[pg * 64 + p], dt = expf(log_step[pg]);
    const float mag = expf(lr * dt), are = mag * cosf(li * dt), aim = mag * sinf(li * dt);
    const float den = lr * lr + li * li, nr = are - 1.0f;
    const float cre = (nr * lr + aim * li) / den, cim = (aim * lr - nr * li) / den;
    float bbr[16], bbi[16], cr[16], ci[16], dsk = 0.f;
#pragma unroll
    for (int h = 0; h < 16; ++h) {
        const float br = b_re[(pg * 64 + p) * 16 + h], bi = b_im[(pg * 64 + p) * 16 + h];
        bbr[h] = cre * br - cim * bi; bbi[h] = cre * bi + cim * br;
        cr[h] = c_re[(pg * 16 + h) * 64 + p]; ci[h] = c_im[(pg * 16 + h) * 64 + p];
    }
    if (p < 16) dsk = d_skip[g * 16 + p];
    float sr = 0.f, si = 0.f;
    const bf16_t* up = Ugm + ((size_t)g * M_TOK + start) * 16;
    for (int i = 0; i < len; ++i) {
        const int t = dir ? (len - 1 - i) : i;
        const uint4 w0 = *(const uint4*)(up + (size_t)t * 16), w1 = *(const uint4*)(up + (size_t)t * 16 + 8);
        float u[16];
        u[0] = bflo(w0.x); u[1] = bfhi(w0.x); u[2] = bflo(w0.y); u[3] = bfhi(w0.y); u[4] = bflo(w0.z); u[5] = bfhi(w0.z); u[6] = bflo(w0.w); u[7] = bfhi(w0.w);
        u[8] = bflo(w1.x); u[9] = bfhi(w1.x); u[10] = bflo(w1.y); u[11] = bfhi(w1.y); u[12] = bflo(w1.z); u[13] = bfhi(w1.z); u[14] = bflo(w1.w); u[15] = bfhi(w1.w);
        float bur = 0.f, bui = 0.f;
#pragma unroll
        for (int h = 0; h < 16; ++h) { bur += u[h] * bbr[h]; bui += u[h] * bbi[h]; }
        const float nsr = are * sr - aim * si + bur, nsi = are * si + aim * sr + bui;
        sr = nsr; si = nsi;
        float mine = 0.f;
#pragma unroll
        for (int h = 0; h < 16; ++h) {
            float c = cr[h] * sr - ci[h] * si;
#pragma unroll
            for (int o = 32; o >= 1; o >>= 1) c += __shfl_xor(c, o);
            if (p == h) mine = c;
        }
        const size_t idx = (size_t)(start + t) * 512 + g * 16 + (p & 15);
        if (dir) { if (p < 16) ytmp[idx] = mine; }
        else {
            float uu = 0.f;
#pragma unroll
            for (int h = 0; h < 16; ++h) if (p == h) uu = u[h];
            if (p < 16) { const float y = dsk * uu + ytmp[idx] + mine; G[idx] = f2bf(gelu_tanh_f(y)); }
        }
    }
}
__device__ __forceinline__ void ssm_naive_phase(int dir, int wave, int lane, int G) {
    const KA a; unsigned char* ws = a.ws();
    for (int it = blockIdx.x * 8 + wave; it < 48 * 32; it += G * 8) {
        int seq, g; if (it < 16 * 32) { seq = 32 + (it >> 5); g = it & 31; } else { const int r = it - 16 * 32; seq = r >> 5; g = r & 31; }
        ssm_naive_item(dir, seq, g, lane, (const bf16_t*)(ws + OFF_UGM), a.in(4), a.in(5), a.in(6), a.in(7), a.in(8), a.in(9), a.in(10), a.in(11), (float*)(ws + OFF_A), (bf16_t*)(ws + OFF_G));
    }
}

__device__ __forceinline__ int t5_bucket(int rel) {
    const int n = rel < 0 ? -rel : rel; int b = rel > 0 ? 16 : 0;
    if (n < 8) return b + n;
    const float nf = (float)n;
    int large = 8 + (int)(logf(nf / 8.0f) / 2.772588722239781f * 8.0f);
    if (large > 15) large = 15;
    return b + large;
}
__device__ __forceinline__ void attn_naive_phase(LAS unsigned char* lds, int G) {
    const KA a; unsigned char* ws = a.ws();
    const bf16_t* Q = (const bf16_t*)(ws + OFF_Q); const bf16_t* Kb = (const bf16_t*)(ws + OFF_KB); const bf16_t* Vt = (const bf16_t*)(ws + OFF_VT); const bf16_t* AZ = (const bf16_t*)(ws + OFF_AZ);
    bf16_t* MIX = (bf16_t*)(ws + OFF_A);
    const float* sink = a.in(15); const float* rel_bias = a.in(18);
    LAS float* qs = (LAS float*)lds;
    LAS float* ps = (LAS float*)(lds + 2048);
    LAS float* ssq = (LAS float*)(lds + 2048 + 10240);
    const int hq = threadIdx.x >> 6, lane = threadIdx.x & 63, kvh = hq >> 2;
    for (int t = blockIdx.x; t < M_TOK; t += G) {
        int start, len; tok_seq(t, start, len);
        const int pos = t - start;
        qs[hq * 64 + lane] = bf2f(Q[(size_t)t * 512 + hq * 64 + lane]);
        __syncthreads();
        float sc[5]; float mx = sink[hq];
#pragma unroll
        for (int i = 0; i < 5; ++i) {
            const int rel = lane + 64 * i - 128; const int kp = pos + rel;
            float s = -1e30f;
            if (rel <= 128 && kp >= 0 && kp < len) {
                const bf16_t* kr = Kb + (size_t)(start + kp) * 128 + kvh * 64;
                float d = 0.f;
                for (int j = 0; j < 64; j += 8) {
                    const uint4 w = *(const uint4*)(kr + j);
                    d += qs[hq * 64 + j + 0] * bflo(w.x) + qs[hq * 64 + j + 1] * bfhi(w.x) + qs[hq * 64 + j + 2] * bflo(w.y) + qs[hq * 64 + j + 3] * bfhi(w.y)
                       + qs[hq * 64 + j + 4] * bflo(w.z) + qs[hq * 64 + j + 5] * bfhi(w.z) + qs[hq * 64 + j + 6] * bflo(w.w) + qs[hq * 64 + j + 7] * bfhi(w.w);
                }
                s = d + rel_bias[t5_bucket(rel) * 8 + hq];
            }
            sc[i] = s; mx = fmaxf(mx, s);
        }
#pragma unroll
        for (int o = 32; o >= 1; o >>= 1) mx = fmaxf(mx, __shfl_xor(mx, o));
        float sum = 0.f;
#pragma unroll
        for (int i = 0; i < 5; ++i) { const float pv = (sc[i] > -1e29f) ? __expf(sc[i] - mx) : 0.f; sc[i] = pv; sum += pv; }
        sum = wave_sum(sum);
        sum += __expf(sink[hq] - mx);
        const float inv = 1.0f / sum;
#pragma unroll
        for (int i = 0; i < 5; ++i) ps[hq * 320 + lane + 64 * i] = sc[i] * inv;
        __syncthreads();
        float o = 0.f;
        const bf16_t* vr = Vt + (size_t)(kvh * 64 + lane) * M_TOK + start;
        for (int j = 0; j < 257; ++j) {
            const int kp = pos + j - 128;
            if (kp >= 0 && kp < len) o += ps[hq * 320 + j] * bf2f(vr[kp]);
        }
        const float sq = wave_sum(o * o);
        if (lane == 0) ssq[hq] = sq;
        __syncthreads();
        float tot = 0.f;
#pragma unroll
        for (int i = 0; i < 8; ++i) tot += ssq[i];
        const float rs = rsqrtf(tot * (1.0f / 512.0f) + RMS_EPS);
        MIX[(size_t)t * 1024 + 512 + hq * 64 + lane] = f2bf(o * rs * bf2f(AZ[(size_t)t * 512 + hq * 64 + lane]));
        __syncthreads();
    }
}

__device__ __forceinline__ void final_phase(int wave, int lane, int G) {
    const KA a; const float* rsq2 = (const float*)(a.ws() + OFF_RSQ2); const float* fw = a.in(19); float* outp = a.out();
    f32x4 w[4];
#pragma unroll
    for (int j = 0; j < 4; ++j) w[j] = *(const f32x4*)(fw + j * 256 + lane * 4);
    for (int t = blockIdx.x * 8 + wave; t < M_TOK; t += G * 8) {
        const float rs = rsqrtf(rsq2[t] * (1.0f / DM) + RMS_EPS);
        float* o = outp + (size_t)t * DM;
#pragma unroll
        for (int j = 0; j < 4; ++j) { f32x4 v = *(const f32x4*)(o + j * 256 + lane * 4); v = v * w[j] * rs; *(f32x4*)(o + j * 256 + lane * 4) = v; }
    }
}

constexpr int LDS_BYTES = 147456;
__global__ void __launch_bounds__(512, 2) mega_fwd(Args a_unused) {
    extern __shared__ __attribute__((aligned(16))) unsigned char lds_raw[];
    LAS unsigned char* lds = (LAS unsigned char*)lds_raw;
    cg::grid_group grid = cg::this_grid();
#define WAVE_ID __builtin_amdgcn_readfirstlane(threadIdx.x >> 6)
#define LANE_ID ((int)(threadIdx.x & 63))
#define GRID_N ((int)gridDim.x)

    p0_prologue(lds, WAVE_ID, LANE_ID, GRID_N);
    grid.sync();
    {
        const KA a; unsigned char* ws = a.ws();
        pg8::Gemm g{(const bf16_t*)(ws + OFF_A), (const bf16_t*)(ws + OFF_WIN), M_TOK, NPROJ, DM}; pg8::StaticOrder S; S.init(M_TOK, NPROJ, GRID_N, (int)blockIdx.x);
        pg8::EpiIn E{(bf16_t*)(ws + OFF_UGM), (bf16_t*)(ws + OFF_SZ), (bf16_t*)(ws + OFF_Q), (bf16_t*)(ws + OFF_KB), (bf16_t*)(ws + OFF_VT), (bf16_t*)(ws + OFF_AZ)};
        pg8::gemm_phase<pg8::EpiIn, pg8::StaticOrder, true, true>(lds, g, S, E);
    }
    grid.sync();
    ssm_naive_phase(1, WAVE_ID, LANE_ID, GRID_N);
    grid.sync();
    ssm_naive_phase(0, WAVE_ID, LANE_ID, GRID_N);
    grid.sync();
    attn_naive_phase(lds, GRID_N);
    grid.sync();
    {
        const KA a; unsigned char* ws = a.ws();
        pg8::Gemm g{(const bf16_t*)(ws + OFF_G), (const bf16_t*)(ws + OFF_WGLU), M_TOK, 512, 512}; pg8::StaticOrder S; S.init(M_TOK, 512, GRID_N, (int)blockIdx.x);
        pg8::EpiGlu E{(const bf16_t*)(ws + OFF_G), (const bf16_t*)(ws + OFF_SZ), a.in(13), (bf16_t*)(ws + OFF_A), (float*)(ws + OFF_RSQ1)};
        pg8::gemm_phase<pg8::EpiGlu, pg8::StaticOrder, true, true>(lds, g, S, E);
    }
    grid.sync();
    {
        const KA a; unsigned char* ws = a.ws();
        pg8::Gemm g{(const bf16_t*)(ws + OFF_A), (const bf16_t*)(ws + OFF_WOUT), M_TOK, DM, DM}; pg8::StaticOrder S; S.init(M_TOK, DM, GRID_N, (int)blockIdx.x);
        pg8::EpiOut E{a.in(0), a.in(1), a.out(), (const float*)(ws + OFF_RSQ1), (float*)(ws + OFF_RSQ2)};
        pg8::gemm_phase<pg8::EpiOut, pg8::StaticOrder, true, true>(lds, g, S, E);
    }
    grid.sync();
    final_phase(WAVE_ID, LANE_ID, GRID_N);
}

extern "C" void kernel_launch(void* const* d_in, const int* in_sizes, int n_in, void* d_out, int out_size, void* d_ws, size_t ws_size, hipStream_t stream) {
    (void)in_sizes; (void)out_size;
    static int grid = 0;
    if (grid == 0) {
        if (n_in != 20 || ws_size < OFF_END) { fprintf(stderr, "kernel_launch: bad arguments (n_in %d, ws %zu < %zu)\n", n_in, ws_size, (size_t)OFF_END); grid = -1; return; }
        int dev = 0, cus = 0, per_cu = 0;
        if (hipGetDevice(&dev) != hipSuccess || hipDeviceGetAttribute(&cus, hipDeviceAttributeMultiprocessorCount, dev) != hipSuccess) { grid = -1; return; }
        if (hipFuncSetAttribute((const void*)mega_fwd, hipFuncAttributeMaxDynamicSharedMemorySize, LDS_BYTES) != hipSuccess) { fprintf(stderr, "kernel_launch: hipFuncSetAttribute failed\n"); grid = -1; return; }
        if (hipOccupancyMaxActiveBlocksPerMultiprocessor(&per_cu, (const void*)mega_fwd, 512, LDS_BYTES) != hipSuccess || per_cu < 1) { fprintf(stderr, "kernel_launch: occupancy query says %d\n", per_cu); grid = -1; return; }
        grid = cus * per_cu;
    }
    if (grid < 0) return;
    Args a{};
    for (int i = 0; i < 20; ++i) a.in[i] = (const float*)d_in[i];
    a.out = (float*)d_out; a.ws = (unsigned char*)d_ws;
    void* args[] = {&a};
    hipError_t e = hipLaunchCooperativeKernel((const void*)mega_fwd, dim3(grid), dim3(512), args, LDS_BYTES, stream);
    if (e != hipSuccess) fprintf(stderr, "cooperative launch failed: %s (grid %d)\n", hipGetErrorString(e), grid);
}
```

```cpp
#include <hip/hip_runtime.h>
#include <hip/hip_cooperative_groups.h>
#include <stdint.h>
#include <stdio.h>
namespace cg = cooperative_groups;

typedef unsigned short bf16_t;
typedef short bf16x8 __attribute__((ext_vector_type(8)));
typedef float f32x16 __attribute__((ext_vector_type(16)));
typedef float f32x4 __attribute__((ext_vector_type(4)));
typedef unsigned u32x4 __attribute__((ext_vector_type(4)));
#define LAS __attribute__((address_space(3)))

constexpr int M_TOK = 131072;
constexpr int M_PROMPT = 65536;
constexpr int DM = 1024;
constexpr int NPROJ = 2304;
constexpr float RMS_EPS = 1e-6f;

__device__ __forceinline__ bf16_t f2bf(float f) { uint32_t u = __float_as_uint(f); u += 0x7fffu + ((u >> 16) & 1u); return (bf16_t)(u >> 16); }
__device__ __forceinline__ float bf2f(bf16_t b) { return __uint_as_float(((uint32_t)b) << 16); }
__device__ __forceinline__ float bflo(unsigned w) { return __uint_as_float(w << 16); }
__device__ __forceinline__ float bfhi(unsigned w) { return __uint_as_float(w & 0xffff0000u); }
__device__ __forceinline__ unsigned cvt_pk_bf16(float lo, float hi) { unsigned r; asm volatile("v_cvt_pk_bf16_f32 %0, %1, %2" : "=v"(r) : "v"(lo), "v"(hi)); return r; }
__device__ __forceinline__ float silu_f(float v) { return v / (1.0f + __expf(-v)); }
__device__ __forceinline__ float sigmoid_f(float v) { return 1.0f / (1.0f + __expf(-v)); }
__device__ __forceinline__ float gelu_tanh_f(float x) { const float u = 0.7978845608028654f * (x + 0.044715f * x * x * x); return 0.5f * x * (1.0f + tanhf(u)); }
__device__ __forceinline__ void tok_seq(int t, int& start, int& len) {
    if (t < M_PROMPT) { len = 2048; start = t & ~2047; } else { len = 4096; start = M_PROMPT + ((t - M_PROMPT) & ~4095); }
}

constexpr size_t MiB = 1024 * 1024;
constexpr size_t OFF_A    = 0;
constexpr size_t OFF_UGM  = 256 * MiB;
constexpr size_t OFF_SZ   = OFF_UGM + 128 * MiB;
constexpr size_t OFF_Q    = OFF_SZ + 128 * MiB;
constexpr size_t OFF_KB   = OFF_Q + 128 * MiB;
constexpr size_t OFF_VT   = OFF_KB + 32 * MiB;
constexpr size_t OFF_AZ   = OFF_VT + 32 * MiB;
constexpr size_t OFF_G    = OFF_AZ + 128 * MiB;
constexpr size_t OFF_WIN  = OFF_G + 128 * MiB;
constexpr size_t OFF_WGLU = OFF_WIN + 5 * MiB;
constexpr size_t OFF_WOUT = OFF_WGLU + 1 * MiB;
constexpr size_t OFF_RSQ1 = OFF_WOUT + 2 * MiB;
constexpr size_t OFF_RSQ2 = OFF_RSQ1 + 512 * 1024;
constexpr size_t OFF_END  = OFF_RSQ2 + 512 * 1024;

namespace pg8 {
#define PG8_LAS __attribute__((address_space(3)))
typedef unsigned short bf16_t;
typedef short bf16x8 __attribute__((ext_vector_type(8)));
typedef float f32x4 __attribute__((ext_vector_type(4)));
typedef unsigned u32x4 __attribute__((ext_vector_type(4)));
constexpr int BM = 256, BK = 64, HALF = 128, HTB = HALF * BK * 2  , STAGE_BYTES = 8 * HTB, NXCD = 8, WGM = 8;

__host__ __device__ __forceinline__ int lds_byte(int r, int c) { const int st = (r >> 4) * 2 + (c >> 5), rr = r & 15, cc = c & 31, ob = rr * 64 + cc * 2; return st * 1024 + (ob ^ (((ob >> 9) & 1) << 5)); }
__host__ __device__ __forceinline__ void stage_rc(int b, int& R, int& C) { const int st = b / 1024, sb = b % 1024, swz = sb ^ (((sb >> 9) & 1) << 5); R = (st >> 1) * 16 + swz / 64; C = (st & 1) * 32 + (swz % 64) / 2; }
__host__ __device__ __forceinline__ int perm32(int rho) { const int n = rho >> 4, i = rho & 15; return 8 * (i >> 2) + 4 * n + (i & 3); }

struct Unit { int pm, pn; };
struct Gemm { const bf16_t* A; const bf16_t* Bt; int M, N, K; };

struct StaticOrder {
    int nM, nN, nwg, G, c;
    __host__ __device__ void init(int M, int N, int G_, int c_) { nM = M / BM; nN = N / BM; nwg = nM * nN; G = G_; c = c_; }
    __host__ __device__ bool next(int i, Unit& u) const {
        const long L = (long)i * G + c; if (L >= nwg) return false;
        int wgid = (int)L; { const int q = nwg / NXCD, r = nwg % NXCD, xcd = wgid % NXCD, off = wgid / NXCD; wgid = (xcd < r ? xcd * (q + 1) : r * (q + 1) + (xcd - r) * q) + off; }
        const int nig = WGM * nN, gid = wgid / nig, fm = gid * WGM, gsz = (nM - fm) < WGM ? (nM - fm) : WGM;
        u.pm = fm + ((wgid % nig) % gsz); u.pn = (wgid % nig) / gsz; return true;
    }
    __device__ __forceinline__ void a_ready(const Unit&) const {}
    __device__ __forceinline__ void done(const Unit&) const {}
};


__device__ __forceinline__ u32x4 pack8(const f32x4 a, const f32x4 b) { u32x4 w; w.x = ::cvt_pk_bf16(a[0], a[1]); w.y = ::cvt_pk_bf16(a[2], a[3]); w.z = ::cvt_pk_bf16(b[0], b[1]); w.w = ::cvt_pk_bf16(b[2], b[3]); return w; }
__device__ __forceinline__ f32x4 silu4(const f32x4 v) { f32x4 r; r[0] = ::silu_f(v[0]); r[1] = ::silu_f(v[1]); r[2] = ::silu_f(v[2]); r[3] = ::silu_f(v[3]); return r; }

struct EpiIn {
    static constexpr bool PERM = true, AFTER_DRAIN = false, MIDK = false;
    bf16_t *Ugm, *SZ, *Q, *Kb, *Vt, *AZ;
    __device__ __forceinline__ void operator()(const f32x4 (&acc)[2][2][4][2], const Unit& u, int wr, int wc, int fr, int fq) const {
        asm volatile("" : "+v"(fr), "+v"(fq));
        const int row0 = u.pm * BM + wr * 64 + fr, cl = wc * 32 + 8 * fq, pn = u.pn;
#pragma unroll
        for (int ai = 0; ai < 2; ++ai)
#pragma unroll
            for (int m = 0; m < 4; ++m) {
                const size_t row = (size_t)(row0 + ai * HALF + m * 16);
#pragma unroll
                for (int bj = 0; bj < 2; ++bj) {
                    const f32x4 v0 = acc[ai][bj][m][0], v1 = acc[ai][bj][m][1];
                    const int c = pn * BM + bj * HALF + cl;
                    if (pn < 2) { *(u32x4*)(Ugm + ((size_t)(c >> 4) * M_TOK + row) * 16 + (c & 15)) = pack8(v0, v1); }
                    else if (pn < 4) { *(u32x4*)(SZ + row * 512 + (c - 512)) = pack8(silu4(v0), silu4(v1)); }
                    else if (pn < 6) { *(u32x4*)(Q + row * 512 + (c - 1024)) = pack8(v0 * 0.125f, v1 * 0.125f); }
                    else if (pn == 6) {
                        if (bj == 0) { *(u32x4*)(Kb + row * 128 + cl) = pack8(v0, v1); }
                        else {
                            bf16_t* vp = Vt + (size_t)cl * M_TOK + row;
#pragma unroll
                            for (int j = 0; j < 4; ++j) { vp[(size_t)j * M_TOK] = ::f2bf(v0[j]); vp[(size_t)(j + 4) * M_TOK] = ::f2bf(v1[j]); }
                        }
                    }
                    else { *(u32x4*)(AZ + row * 512 + (c - 1792)) = pack8(silu4(v0), silu4(v1)); }
                }
            }
    }
};

struct EpiGlu {
    static constexpr bool PERM = true, AFTER_DRAIN = false, MIDK = false;
    const bf16_t *G, *SZ; const float* b_glu; bf16_t* MIX; float* rsq1;
    __device__ __forceinline__ void operator()(const f32x4 (&acc)[2][2][4][2], const Unit& u, int wr, int wc, int fr, int fq) const {
        asm volatile("" : "+v"(fr), "+v"(fq));
        const int row0 = u.pm * BM + wr * 64 + fr, cl = wc * 32 + 8 * fq, pn = u.pn;
        f32x4 bv[2][2];
#pragma unroll
        for (int bj = 0; bj < 2; ++bj) { bv[bj][0] = *(const f32x4*)(b_glu + pn * BM + bj * HALF + cl); bv[bj][1] = *(const f32x4*)(b_glu + pn * BM + bj * HALF + cl + 4); }
#pragma unroll
        for (int ai = 0; ai < 2; ++ai)
#pragma unroll
            for (int m = 0; m < 4; ++m) {
                const size_t row = (size_t)(row0 + ai * HALF + m * 16);
                float sq = 0.f;
#pragma unroll
                for (int bj = 0; bj < 2; ++bj) {
                    const int c = pn * BM + bj * HALF + cl;
                    const u32x4 gw = *(const u32x4*)(G + row * 512 + c), zw = *(const u32x4*)(SZ + row * 512 + c);
                    const f32x4 a0 = acc[ai][bj][m][0] + bv[bj][0], a1 = acc[ai][bj][m][1] + bv[bj][1];
                    f32x4 g0, g1, z0, z1;
                    g0[0] = ::bflo(gw.x); g0[1] = ::bfhi(gw.x); g0[2] = ::bflo(gw.y); g0[3] = ::bfhi(gw.y); g1[0] = ::bflo(gw.z); g1[1] = ::bfhi(gw.z); g1[2] = ::bflo(gw.w); g1[3] = ::bfhi(gw.w);
                    z0[0] = ::bflo(zw.x); z0[1] = ::bfhi(zw.x); z0[2] = ::bflo(zw.y); z0[3] = ::bfhi(zw.y); z1[0] = ::bflo(zw.z); z1[1] = ::bfhi(zw.z); z1[2] = ::bflo(zw.w); z1[3] = ::bfhi(zw.w);
                    f32x4 v0, v1;
#pragma unroll
                    for (int j = 0; j < 4; ++j) { v0[j] = g0[j] * ::sigmoid_f(a0[j]); v1[j] = g1[j] * ::sigmoid_f(a1[j]); sq += v0[j] * v0[j] + v1[j] * v1[j]; }
                    *(u32x4*)(MIX + row * 1024 + c) = pack8(v0 * z0, v1 * z1);
                }
                sq += __shfl_xor(sq, 16); sq += __shfl_xor(sq, 32);
                if (fq == 0) atomicAdd(rsq1 + row, sq);
                if (m & 1) asm volatile("" ::: "memory");
            }
    }
};

struct EpiOut {
    static constexpr bool PERM = false, AFTER_DRAIN = false, MIDK = true;
    const float *xp, *xs; float* out; const float* rsq1; float* rsq2;
    __device__ __forceinline__ void mid(f32x4 (&acc)[2][2][4][2], const Unit& u, int wr, int wc, int fr, int fq) const {
        asm volatile("" : "+v"(fr));
#pragma unroll
        for (int ai = 0; ai < 2; ++ai)
#pragma unroll
            for (int m = 0; m < 4; ++m) {
                const int row = u.pm * BM + ai * HALF + wr * 64 + m * 16 + fr;
                const float rs = rsqrtf(rsq1[row] * (1.0f / 512.0f) + ::RMS_EPS);
#pragma unroll
                for (int bj = 0; bj < 2; ++bj)
#pragma unroll
                    for (int n = 0; n < 2; ++n) acc[ai][bj][m][n] = acc[ai][bj][m][n] * rs;
            }
    }
    __device__ __forceinline__ void operator()(const f32x4 (&acc)[2][2][4][2], const Unit& u, int wr, int wc, int fr, int fq) const {
        asm volatile("" : "+v"(fr), "+v"(fq));
        const int col0 = u.pn * BM + wc * 32 + 4 * fq, r0 = u.pm * BM;
        const float* xb = (r0 < ::M_PROMPT) ? xp + (size_t)r0 * 1024 : xs + (size_t)(r0 - ::M_PROMPT) * 1024;
        float* ob = out + (size_t)r0 * 1024;
#pragma unroll
        for (int ai = 0; ai < 2; ++ai)
#pragma unroll
            for (int m = 0; m < 4; ++m) {
                const int rl = ai * HALF + wr * 64 + m * 16 + fr;
                float sq = 0.f;
#pragma unroll
                for (int bj = 0; bj < 2; ++bj)
#pragma unroll
                    for (int n = 0; n < 2; ++n) {
                        const size_t off = (size_t)rl * 1024 + col0 + bj * HALF + n * 16;
                        const f32x4 r = *(const f32x4*)(xb + off) + acc[ai][bj][m][n];
                        *(f32x4*)(ob + off) = r;
                        sq += (r[0] * r[0] + r[1] * r[1]) + (r[2] * r[2] + r[3] * r[3]);
                    }
                sq += __shfl_xor(sq, 16); sq += __shfl_xor(sq, 32);
                if (fq == 0) atomicAdd(rsq2 + r0 + rl, sq);
                if (m & 1) asm volatile("" ::: "memory");
            }
    }
};

template <class Epi, class Sched, bool ALIGN_EPI = false, bool SP2 = false>
__device__ __forceinline__ void gemm_phase(PG8_LAS unsigned char* lds, const Gemm g, const Sched& S, const Epi& E) {
    const int tid = threadIdx.x, wid = __builtin_amdgcn_readfirstlane(tid >> 6), lane = tid & 63, wr = wid >> 2, wc = wid & 3, fr = lane & 15, fq = lane >> 4;
    const int K = g.K, nt = K / BK;
    unsigned voffA[2], voffB[2];
#pragma unroll
    for (int i = 0; i < 2; ++i) { int R, C; stage_rc(tid * 16 + i * 8192, R, C); const int Rb = Epi::PERM ? ((R & ~31) + perm32(R & 31)) : R;
        voffA[i] = (unsigned)(R * K + C) * 2u; voffB[i] = (unsigned)(Rb * K + C) * 2u; }
    const size_t kstep = (size_t)(BK * 2);
    const size_t hstep = (size_t)HALF * K * 2;
    const size_t tstep = 2 * hstep;
    const unsigned ldsw = (unsigned)wid * 1024u;
    const int aoff = lds_byte(wr * 64 + fr, fq * 8), boff = lds_byte(wc * 32 + fr, fq * 8);
#define PG8_SA(b, h) (((b) * 2 + (h)) * HTB)
#define PG8_SB(b, h) ((4 + (b) * 2 + (h)) * HTB)
#define PG8_STAGE(bufoff, gbase, voff) do { _Pragma("unroll") for (int _i = 0; _i < 2; ++_i) \
        __builtin_amdgcn_global_load_lds((const unsigned*)((const char*)(gbase) + (voff)[_i]), (PG8_LAS unsigned*)(lds + (bufoff) + ldsw + _i * 8192), 16, 0, 0); } while (0)
#define PG8_LDA(dst, b, h) do { _Pragma("unroll") for (int m = 0; m < 4; ++m) _Pragma("unroll") for (int k = 0; k < 2; ++k) dst[m][k] = *(const PG8_LAS bf16x8*)(lds + PG8_SA(b, h) + aoff + m * 2048 + k * 1024); } while (0)
#define PG8_LDB(dst, b, h) do { _Pragma("unroll") for (int n = 0; n < 2; ++n) _Pragma("unroll") for (int k = 0; k < 2; ++k) dst[n][k] = *(const PG8_LAS bf16x8*)(lds + PG8_SB(b, h) + boff + n * 2048 + k * 1024); } while (0)
#define PG8_MMA(ai, bj, At, Bt) do { __builtin_amdgcn_s_setprio(1); _Pragma("unroll") for (int m = 0; m < 4; ++m) _Pragma("unroll") for (int n = 0; n < 2; ++n) _Pragma("unroll") for (int k = 0; k < 2; ++k) \
        acc[ai][bj][m][n] = __builtin_amdgcn_mfma_f32_16x16x32_bf16(Bt[n][k], At[m][k], acc[ai][bj][m][n], 0, 0, 0); __builtin_amdgcn_s_setprio(0); } while (0)
#define PG8_WAIT_V(n) asm volatile("s_waitcnt vmcnt(" #n ")" ::: "memory")
#define PG8_WAIT_L(n) asm volatile("s_waitcnt lgkmcnt(" #n ")" ::: "memory")
#define PG8_BAR __builtin_amdgcn_s_barrier()
#define PG8_SCHED __builtin_amdgcn_sched_barrier(0)
    Unit cur, nxt; int ui = 0;
    if (!S.next(0, cur)) return;
    f32x4 acc[2][2][4][2];
#pragma unroll
    for (int a = 0; a < 2; ++a)
#pragma unroll
        for (int b = 0; b < 2; ++b)
#pragma unroll
            for (int m = 0; m < 4; ++m)
#pragma unroll
                for (int n = 0; n < 2; ++n) acc[a][b][m][n] = (f32x4){0.f, 0.f, 0.f, 0.f};
    bf16x8 At[4][2], B0[2][2], B1[2][2];
    const char* cA = (const char*)g.A + (size_t)cur.pm * tstep; const char* cB = (const char*)g.Bt + (size_t)cur.pn * tstep;
    S.a_ready(cur);
    if constexpr (SP2) {
        PG8_STAGE(PG8_SB(0, 0), cB, voffB); PG8_STAGE(PG8_SB(0, 1), cB + hstep, voffB); PG8_STAGE(PG8_SA(0, 0), cA, voffA); PG8_STAGE(PG8_SA(0, 1), cA + hstep, voffA);
        if (wr == 1) PG8_BAR;
        PG8_WAIT_V(2); PG8_BAR;
        PG8_STAGE(PG8_SB(1, 0), cB + kstep, voffB); PG8_STAGE(PG8_SA(1, 0), cA + kstep, voffA); PG8_STAGE(PG8_SB(1, 1), cB + hstep + kstep, voffB);
        PG8_WAIT_V(6); PG8_BAR;
    } else {
        PG8_STAGE(PG8_SB(0, 0), cB, voffB); PG8_STAGE(PG8_SA(0, 0), cA, voffA); PG8_STAGE(PG8_SB(0, 1), cB + hstep, voffB); PG8_STAGE(PG8_SA(0, 1), cA + hstep, voffA);
        if (wr == 1) PG8_BAR;
        PG8_WAIT_V(4); PG8_BAR;
        PG8_STAGE(PG8_SB(1, 0), cB + kstep, voffB); PG8_STAGE(PG8_SA(1, 0), cA + kstep, voffA); PG8_STAGE(PG8_SB(1, 1), cB + hstep + kstep, voffB);
        PG8_WAIT_V(6); PG8_BAR;
    }
    for (;;) {
        const bool has_next = S.next(ui + 1, nxt);
        const char* nA = has_next ? (const char*)g.A + (size_t)nxt.pm * tstep : cA; const char* nB = has_next ? (const char*)g.Bt + (size_t)nxt.pn * tstep : cB;
        for (int t = 0; t < nt; t += 2) {
            if constexpr (Epi::MIDK) { if (t == (nt >> 1)) E.mid(acc, cur, wr, wc, fr, fq); }
            const bool last = (t == nt - 2);
            const char* a1 = cA + (size_t)(t + 1) * kstep;
            const char* a2 = last ? nA : cA + (size_t)(t + 2) * kstep; const char* b2 = last ? nB : cB + (size_t)(t + 2) * kstep;
            const char* a3 = a2 + kstep; const char* b3 = b2 + kstep;
            if (last && has_next) S.a_ready(nxt);
            if constexpr (SP2) {
            PG8_LDB(B0, 0, 0); PG8_LDB(B1, 0, 1); PG8_SCHED; PG8_LDA(At, 0, 0); PG8_STAGE(PG8_SA(1, 1), a1 + hstep, voffA);
            PG8_WAIT_V(8); PG8_WAIT_L(0); PG8_BAR; PG8_MMA(0, 0, At, B0); PG8_MMA(0, 1, At, B1); PG8_BAR; PG8_SCHED;
            PG8_LDA(At, 0, 1); PG8_STAGE(PG8_SB(0, 0), b2, voffB); PG8_STAGE(PG8_SB(0, 1), b2 + hstep, voffB); PG8_STAGE(PG8_SA(0, 0), a2, voffA);
            PG8_WAIT_V(8); PG8_WAIT_L(0); PG8_BAR; PG8_MMA(1, 0, At, B0); PG8_MMA(1, 1, At, B1); PG8_BAR; PG8_SCHED;
            PG8_LDB(B0, 1, 0); PG8_LDB(B1, 1, 1); PG8_SCHED; PG8_LDA(At, 1, 0); PG8_STAGE(PG8_SA(0, 1), a2 + hstep, voffA);
            PG8_WAIT_V(8); PG8_WAIT_L(0); PG8_BAR; PG8_MMA(0, 0, At, B0); PG8_MMA(0, 1, At, B1); PG8_BAR; PG8_SCHED;
            PG8_LDA(At, 1, 1); PG8_STAGE(PG8_SB(1, 0), b3, voffB); PG8_STAGE(PG8_SB(1, 1), b3 + hstep, voffB); PG8_STAGE(PG8_SA(1, 0), a3, voffA);
            PG8_WAIT_V(8); PG8_WAIT_L(0); PG8_BAR; PG8_MMA(1, 0, At, B0); PG8_MMA(1, 1, At, B1); PG8_BAR; PG8_SCHED;
            } else {
            PG8_LDB(B0, 0, 0); PG8_SCHED; PG8_LDA(At, 0, 0); PG8_STAGE(PG8_SA(1, 1), a1 + hstep, voffA);
            PG8_WAIT_L(8); PG8_BAR; PG8_WAIT_L(0); PG8_MMA(0, 0, At, B0); PG8_BAR; PG8_SCHED;
            PG8_LDB(B1, 0, 1); PG8_STAGE(PG8_SB(0, 0), b2, voffB);
            PG8_BAR; PG8_WAIT_L(0); PG8_MMA(0, 1, At, B1); PG8_BAR;
            PG8_LDA(At, 0, 1); PG8_STAGE(PG8_SA(0, 0), a2, voffA);
            PG8_BAR; PG8_WAIT_L(0); PG8_MMA(1, 0, At, B0); PG8_BAR; PG8_SCHED;
            PG8_STAGE(PG8_SB(0, 1), b2 + hstep, voffB);
            PG8_WAIT_V(6); PG8_BAR; PG8_MMA(1, 1, At, B1); PG8_BAR;
            PG8_LDB(B0, 1, 0); PG8_SCHED; PG8_LDA(At, 1, 0); PG8_STAGE(PG8_SA(0, 1), a2 + hstep, voffA);
            PG8_WAIT_L(8); PG8_BAR; PG8_WAIT_L(0); PG8_MMA(0, 0, At, B0); PG8_BAR; PG8_SCHED;
            PG8_LDB(B1, 1, 1); PG8_STAGE(PG8_SB(1, 0), b3, voffB);
            PG8_BAR; PG8_WAIT_L(0); PG8_MMA(0, 1, At, B1); PG8_BAR;
            PG8_LDA(At, 1, 1); PG8_STAGE(PG8_SA(1, 0), a3, voffA);
            PG8_BAR; PG8_WAIT_L(0); PG8_MMA(1, 0, At, B0); PG8_BAR; PG8_SCHED;
            PG8_STAGE(PG8_SB(1, 1), b3 + hstep, voffB);
            PG8_WAIT_V(6); PG8_BAR; PG8_MMA(1, 1, At, B1); PG8_BAR;
            }
        }
        if constexpr (ALIGN_EPI) { if (wr == 0) PG8_BAR; }
        if constexpr (!Epi::AFTER_DRAIN) { E(acc, cur, wr, wc, fr, fq); S.done(cur); }
        if (!has_next) break;
#pragma unroll
        for (int a = 0; a < 2; ++a)
#pragma unroll
            for (int b = 0; b < 2; ++b)
#pragma unroll
                for (int m = 0; m < 4; ++m)
#pragma unroll
                    for (int n = 0; n < 2; ++n) acc[a][b][m][n] = (f32x4){0.f, 0.f, 0.f, 0.f};
        cur = nxt; cA = nA; cB = nB; ++ui;
        if constexpr (ALIGN_EPI) { if (wr == 1) PG8_BAR; }
    }
    PG8_WAIT_V(0);
    if constexpr (!ALIGN_EPI) { if (wr == 0) PG8_BAR; }
    PG8_BAR;
    if constexpr (Epi::AFTER_DRAIN) { E.fused(acc, cur, wr, wc, fr, fq, lds, wid, lane); S.done(cur); }
#undef PG8_SA
#undef PG8_SB
#undef PG8_STAGE
#undef PG8_LDA
#undef PG8_LDB
#undef PG8_MMA
#undef PG8_WAIT_V
#undef PG8_WAIT_L
#undef PG8_BAR
#undef PG8_SCHED
}
}

struct Args {
    const float* in[20];
    float* out; unsigned char* ws;
};
typedef const unsigned char __attribute__((address_space(4)))* kptr_t;
struct KA {
    kptr_t p;
    __device__ __forceinline__ KA() { p = (kptr_t)__builtin_amdgcn_kernarg_segment_ptr(); asm volatile("" : "+s"(p)); }
    __device__ __forceinline__ const float* in(int i) const { return *(const float* const __attribute__((address_space(4)))*)(p + 8 * i); }
    __device__ __forceinline__ float* out() const { return *(float* const __attribute__((address_space(4)))*)(p + 160); }
    __device__ __forceinline__ unsigned char* ws() const { return *(unsigned char* const __attribute__((address_space(4)))*)(p + 168); }
};

__device__ __forceinline__ float wave_sum(float v) {
#pragma unroll
    for (int o = 1; o < 64; o <<= 1) v += __shfl_xor(v, o);
    return v;
}

__device__ __forceinline__ void p0_transpose_item(const float* __restrict__ w, int K, int N, const float* __restrict__ s1, const float* __restrict__ s2, int ksplit, bf16_t* __restrict__ out,
                                                  LAS float* scr, int item, int lane) {
    const int nblk = N / 32, kb = item / nblk, nb = item % nblk, k0 = 32 * kb, n0 = 32 * nb;
#pragma unroll 4
    for (int i = 0; i < 16; ++i) {
        const int kk = 2 * i + (lane >> 5), k = k0 + kk; float sc = 1.0f;
        if (s1) sc = (k < ksplit) ? s1[k] : s2[k - ksplit];
        scr[kk * 33 + (lane & 31)] = w[(size_t)k * N + n0 + (lane & 31)] * sc;
    }
    asm volatile("s_waitcnt lgkmcnt(0)" ::: "memory");
#pragma unroll 4
    for (int j = 0; j < 16; ++j) { const int n = 2 * j + (lane >> 5), k = lane & 31; out[(size_t)(n0 + n) * K + k0 + k] = f2bf(scr[k * 33 + n]); }
    asm volatile("s_waitcnt lgkmcnt(0)" ::: "memory");
}

__device__ __forceinline__ void p0_prologue(LAS unsigned char* lds, int wave, int lane, int G) {
    const KA a; unsigned char* ws = a.ws();
    LAS float* scr = (LAS float*)(lds + wave * 4352);
    const int gw = blockIdx.x * 8 + wave, NGW = G * 8;
    constexpr int I_IN = (DM / 32) * (NPROJ / 32), I_GLU = 16 * 16, I_OUT = 32 * 32;
    for (int it = gw; it < I_IN + I_GLU + I_OUT; it += NGW) {
        int r = it;
        if (r < I_IN) { p0_transpose_item(a.in(3), DM, NPROJ, a.in(2), a.in(2), DM, (bf16_t*)(ws + OFF_WIN), scr, r, lane); continue; } r -= I_IN;
        if (r < I_GLU) { p0_transpose_item(a.in(12), 512, 512, nullptr, nullptr, 0, (bf16_t*)(ws + OFF_WGLU), scr, r, lane); continue; } r -= I_GLU;
        p0_transpose_item(a.in(17), DM, DM, a.in(14), a.in(16), 512, (bf16_t*)(ws + OFF_WOUT), scr, r, lane);
    }
    bf16_t* H = (bf16_t*)(ws + OFF_A);
    for (int t = gw; t < M_TOK; t += NGW) {
        const float* x = (t < M_PROMPT) ? a.in(0) + (size_t)t * DM : a.in(1) + (size_t)(t - M_PROMPT) * DM;
        f32x4 v[4]; float s = 0.f;
#pragma unroll
        for (int j = 0; j < 4; ++j) { v[j] = *(const f32x4*)(x + j * 256 + lane * 4); s += (v[j][0] * v[j][0] + v[j][1] * v[j][1]) + (v[j][2] * v[j][2] + v[j][3] * v[j][3]); }
        const float rs = rsqrtf(wave_sum(s) * (1.0f / DM) + RMS_EPS);
#pragma unroll
        for (int j = 0; j < 4; ++j) { uint2 w; w.x = cvt_pk_bf16(v[j][0] * rs, v[j][1] * rs); w.y = cvt_pk_bf16(v[j][2] * rs, v[j][3] * rs); *(uint2*)(H + (size_t)t * DM + j * 256 + lane * 4) = w; }
    }
    float* rsq = (float*)(ws + OFF_RSQ1);
    for (int i = blockIdx.x * 512 + threadIdx.x; i < 2 * M_TOK; i += G * 512) rsq[i] = 0.f;
}

__device__ __forceinline__ void ssm_naive_item(int dir, int seq, int g, int p, const bf16_t* __restrict__ Ugm, const float* __restrict__ lam_re, const float* __restrict__ lam_im, const float* __restrict__ log_step,
                                               const float* __restrict__ b_re, const float* __restrict__ b_im, const float* __restrict__ c_re, const float* __restrict__ c_im,
                                               const float* __restrict__ d_skip, float* __restrict__ ytmp, bf16_t* __restrict__ G) {
    int start, len; if (seq < 32) { start = seq * 2048; len = 2048; } else { start = M_PROMPT + (seq - 32) * 4096; len = 4096; }
    const int pg = (dir * 32 + g);
    const float lr = lam_re[pg * 64 + p], li = lam_im[pg * 64 + p], dt = expf(log_step[pg]);
    const float mag = expf(lr * dt), are = mag * cosf(li * dt), aim = mag * sinf(li * dt);
    const float den = lr * lr + li * li, nr = are - 1.0f;
    const float cre = (nr * lr + aim * li) / den, cim = (aim * lr - nr * li) / den;
    float bbr[16], bbi[16], cr[16], ci[16], dsk = 0.f;
#pragma unroll
    for (int h = 0; h < 16; ++h) {
        const float br = b_re[(pg * 64 + p) * 16 + h], bi = b_im[(pg * 64 + p) * 16 + h];
        bbr[h] = cre * br - cim * bi; bbi[h] = cre * bi + cim * br;
        cr[h] = c_re[(pg * 16 + h) * 64 + p]; ci[h] = c_im[(pg * 16 + h) * 64 + p];
    }
    if (p < 16) dsk = d_skip[g * 16 + p];
    float sr = 0.f, si = 0.f;
    const bf16_t* up = Ugm + ((size_t)g * M_TOK + start) * 16;
    for (int i = 0; i < len; ++i) {
        const int t = dir ? (len - 1 - i) : i;
        const uint4 w0 = *(const uint4*)(up + (size_t)t * 16), w1 = *(const uint4*)(up + (size_t)t * 16 + 8);
        float u[16];
        u[0] = bflo(w0.x); u[1] = bfhi(w0.x); u[2] = bflo(w0.y); u[3] = bfhi(w0.y); u[4] = bflo(w0.z); u[5] = bfhi(w0.z); u[6] = bflo(w0.w); u[7] = bfhi(w0.w);
        u[8] = bflo(w1.x); u[9] = bfhi(w1.x); u[10] = bflo(w1.y); u[11] = bfhi(w1.y); u[12] = bflo(w1.z); u[13] = bfhi(w1.z); u[14] = bflo(w1.w); u[15] = bfhi(w1.w);
        float bur = 0.f, bui = 0.f;
#pragma unroll
        for (int h = 0; h < 16; ++h) { bur += u[h] * bbr[h]; bui += u[h] * bbi[h]; }
        const float nsr = are * sr - aim * si + bur, nsi = are * si + aim * sr + bui;
        sr = nsr; si = nsi;
        float mine = 0.f;
#pragma unroll
        for (int h = 0; h < 16; ++h) {
            float c = cr[h] * sr - ci[h] * si;
#pragma unroll
            for (int o = 32; o >= 1; o >>= 1) c += __shfl_xor(c, o);
            if (p == h) mine = c;
        }
        const size_t idx = (size_t)(start + t) * 512 + g * 16 + (p & 15);
        if (dir) { if (p < 16) ytmp[idx] = mine; }
        else {
            float uu = 0.f;
#pragma unroll
            for (int h = 0; h < 16; ++h) if (p == h) uu = u[h];
            if (p < 16) { const float y = dsk * uu + ytmp[idx] + mine; G[idx] = f2bf(gelu_tanh_f(y)); }
        }
    }
}
__device__ __forceinline__ void ssm_naive_phase(int dir, int wave, int lane, int G) {
    const KA a; unsigned char* ws = a.ws();
    for (int it = blockIdx.x * 8 + wave; it < 48 * 32; it += G * 8) {
        int seq, g; if (it < 16 * 32) { seq = 32 + (it >> 5); g = it & 31; } else { const int r = it - 16 * 32; seq = r >> 5; g = r & 31; }
        ssm_naive_item(dir, seq, g, lane, (const bf16_t*)(ws + OFF_UGM), a.in(4), a.in(5), a.in(6), a.in(7), a.in(8), a.in(9), a.in(10), a.in(11), (float*)(ws + OFF_A), (bf16_t*)(ws + OFF_G));
    }
}

__device__ __forceinline__ int t5_bucket(int rel) {
    const int n = rel < 0 ? -rel : rel; int b = rel > 0 ? 16 : 0;
    if (n < 8) return b + n;
    const float nf = (float)n;
    int large = 8 + (int)(logf(nf / 8.0f) / 2.772588722239781f * 8.0f);
    if (large > 15) large = 15;
    return b + large;
}
namespace att {
constexpr int L_BIAS = 0, L_K = 10240, L_VT = 28672, L_SSQ = 47104, L_OST = 49152;
constexpr int KROW = 144, VROW = 72, OROW = 144, KBUF = 9216, VBUF = 9216;
typedef unsigned long long u64;

__device__ __forceinline__ void tile(const LAS unsigned char* kb, const LAS unsigned char* vb, const LAS float* btw, const bf16x8 (&q)[4], f32x16& o0, f32x16& o1, float& m, float& l, int delta, int b, int hi) {
    f32x16 p;
#pragma unroll
    for (int r = 0; r < 16; ++r) p[r] = 0.f;
#pragma unroll
    for (int s = 0; s < 4; ++s) { const bf16x8 kf = *(const LAS bf16x8*)(kb + b * KROW + s * 32 + hi * 16); p = __builtin_amdgcn_mfma_f32_32x32x16_bf16(kf, q[s], p, 0, 0, 0); }
    const LAS float* bp = btw + (32 * delta + 32 + 4 * hi - b);
#pragma unroll
    for (int r = 0; r < 16; ++r) p[r] += bp[(r & 3) + 8 * (r >> 2)];
    if (delta == 0) {
#pragma unroll
        for (int r = 0; r < 16; ++r) { const int aa = (r & 3) + 8 * (r >> 2) + 4 * hi; if (aa < b) p[r] = -1e30f; }
    } else if (delta == 8) {
#pragma unroll
        for (int r = 0; r < 16; ++r) { const int aa = (r & 3) + 8 * (r >> 2) + 4 * hi; if (aa > b) p[r] = -1e30f; }
    }
    float tm = p[0];
#pragma unroll
    for (int r = 1; r < 16; ++r) tm = fmaxf(tm, p[r]);
    tm = fmaxf(tm, __shfl_xor(tm, 32));
    const float mn = fmaxf(m, tm), alpha = __expf(m - mn);
    m = mn;
    float rs = 0.f;
#pragma unroll
    for (int r = 0; r < 16; ++r) { p[r] = __expf(p[r] - mn); rs += p[r]; }
    l = l * alpha + rs;
    o0 = o0 * alpha; o1 = o1 * alpha;
    bf16x8 pf[2];
#pragma unroll
    for (int s = 0; s < 2; ++s) {
        u32x4 w; w.x = cvt_pk_bf16(p[8 * s + 0], p[8 * s + 1]); w.y = cvt_pk_bf16(p[8 * s + 2], p[8 * s + 3]); w.z = cvt_pk_bf16(p[8 * s + 4], p[8 * s + 5]); w.w = cvt_pk_bf16(p[8 * s + 6], p[8 * s + 7]);
        pf[s] = __builtin_bit_cast(bf16x8, w);
    }
#pragma unroll
    for (int s = 0; s < 2; ++s) {
        { const LAS unsigned char* vp = vb + b * VROW + 32 * s + 8 * hi; const u64 lo = *(const LAS u64*)vp, hh = *(const LAS u64*)(vp + 16);
          typedef u64 u64x2 __attribute__((ext_vector_type(2))); u64x2 t; t.x = lo; t.y = hh; o0 = __builtin_amdgcn_mfma_f32_32x32x16_bf16(__builtin_bit_cast(bf16x8, t), pf[s], o0, 0, 0, 0); }
        { const LAS unsigned char* vp = vb + (32 + b) * VROW + 32 * s + 8 * hi; const u64 lo = *(const LAS u64*)vp, hh = *(const LAS u64*)(vp + 16);
          typedef u64 u64x2 __attribute__((ext_vector_type(2))); u64x2 t; t.x = lo; t.y = hh; o1 = __builtin_amdgcn_mfma_f32_32x32x16_bf16(__builtin_bit_cast(bf16x8, t), pf[s], o1, 0, 0, 0); }
    }
}

__device__ __forceinline__ void phase(LAS unsigned char* lds, int G) {
    const KA a; unsigned char* ws = a.ws();
    const bf16_t* Q = (const bf16_t*)(ws + OFF_Q); const bf16_t* Kb = (const bf16_t*)(ws + OFF_KB); const bf16_t* Vt = (const bf16_t*)(ws + OFF_VT); const bf16_t* AZ = (const bf16_t*)(ws + OFF_AZ);
    bf16_t* MIX = (bf16_t*)(ws + OFF_A);
    const int tid = threadIdx.x, lane = tid & 63, hq = __builtin_amdgcn_readfirstlane(tid >> 6), kvh = hq >> 2, b = lane & 31, hi = lane >> 5;
    {
        const float* rel_bias = a.in(18);
        LAS float* bt = (LAS float*)(lds + L_BIAS);
        for (int e = tid; e < 8 * 320; e += 512) { const int h = e / 320, rel = (e % 320) - 160; bt[e] = (rel >= -128 && rel <= 128) ? rel_bias[t5_bucket(rel) * 8 + h] : 0.f; }
    }
    const float sinkv = a.in(15)[hq];
    const LAS float* btw = (const LAS float*)(lds + L_BIAS) + hq * 320;
    LAS float* ssq = (LAS float*)(lds + L_SSQ);
    LAS unsigned char* ost = lds + L_OST + hq * (64 * OROW);
    const int kkey = tid >> 4, kchunk = tid & 15, vch = tid >> 2, vpart = tid & 3;
    const int kl = (kchunk >> 3) * (32 * KROW) + kkey * KROW + (kchunk & 7) * 16;
    const int vl = (vch >> 6) * (64 * VROW) + (vch & 63) * VROW + vpart * 16;
    for (int item = blockIdx.x; item < M_TOK / 64; item += G) {
        const int q0 = item * 64; int start, len; tok_seq(q0, start, len); const int end = start + len;
        bf16x8 qf[2][4];
#pragma unroll
        for (int i = 0; i < 2; ++i)
#pragma unroll
            for (int s = 0; s < 4; ++s) qf[i][s] = *(const bf16x8*)(Q + (size_t)(q0 + 32 * i + b) * 512 + hq * 64 + 16 * s + 8 * hi);
        f32x16 o[2][2]; float m[2], l[2];
#pragma unroll
        for (int i = 0; i < 2; ++i) { m[i] = sinkv; l[i] = hi ? 0.f : 1.f;
#pragma unroll
            for (int r = 0; r < 16; ++r) { o[i][0][r] = 0.f; o[i][1][r] = 0.f; } }
        u32x4 kreg, vreg;
        { const int ks = q0 - 128; if (ks >= start && ks < end) { kreg = *(const u32x4*)(Kb + (size_t)(ks + kkey) * 128 + kchunk * 8); vreg = *(const u32x4*)(Vt + (size_t)vch * M_TOK + ks + vpart * 8); } }
        for (int j = 0; j < 10; ++j) {
            const int ks = q0 - 128 + 32 * j; const bool valid = (ks >= start && ks < end);
            const int buf = j & 1;
            if (valid) {
                *(LAS u32x4*)(lds + L_K + buf * KBUF + kl) = kreg;
                typedef u64 u64x2 __attribute__((ext_vector_type(2))); const u64x2 vv = __builtin_bit_cast(u64x2, vreg);
                *(LAS u64*)(lds + L_VT + buf * VBUF + vl) = vv.x; *(LAS u64*)(lds + L_VT + buf * VBUF + vl + 8) = vv.y;
            }
            { const int kn = ks + 32; if (j < 9 && kn >= start && kn < end) { kreg = *(const u32x4*)(Kb + (size_t)(kn + kkey) * 128 + kchunk * 8); vreg = *(const u32x4*)(Vt + (size_t)vch * M_TOK + kn + vpart * 8); } }
            __syncthreads();
            if (valid) {
                const LAS unsigned char* kb = lds + L_K + buf * KBUF + kvh * (32 * KROW);
                const LAS unsigned char* vb = lds + L_VT + buf * VBUF + kvh * (64 * VROW);
                if (j <= 8) tile(kb, vb, btw, qf[0], o[0][0], o[0][1], m[0], l[0], j, b, hi);
                if (j >= 1) tile(kb, vb, btw, qf[1], o[1][0], o[1][1], m[1], l[1], j - 1, b, hi);
            }
        }
#pragma unroll
        for (int i = 0; i < 2; ++i) {
            const float lt = l[i] + __shfl_xor(l[i], 32), inv = 1.0f / lt;
            float ss = 0.f;
#pragma unroll
            for (int r = 0; r < 16; ++r) { o[i][0][r] *= inv; o[i][1][r] *= inv; ss += o[i][0][r] * o[i][0][r] + o[i][1][r] * o[i][1][r]; }
            ss += __shfl_xor(ss, 32);
            if (hi == 0) ssq[(32 * i + b) * 8 + hq] = ss;
        }
        __syncthreads();
#pragma unroll
        for (int i = 0; i < 2; ++i) {
            const f32x4 s0 = *(const LAS f32x4*)(ssq + (32 * i + b) * 8), s1 = *(const LAS f32x4*)(ssq + (32 * i + b) * 8 + 4);
            const float tot = ((s0[0] + s0[1]) + (s0[2] + s0[3])) + ((s1[0] + s1[1]) + (s1[2] + s1[3]));
            const float rstd = rsqrtf(tot * (1.0f / 512.0f) + RMS_EPS);
#pragma unroll
            for (int nt = 0; nt < 2; ++nt)
#pragma unroll
                for (int rg = 0; rg < 4; ++rg) {
                    const u64 w = (u64)cvt_pk_bf16(o[i][nt][4 * rg] * rstd, o[i][nt][4 * rg + 1] * rstd) | ((u64)cvt_pk_bf16(o[i][nt][4 * rg + 2] * rstd, o[i][nt][4 * rg + 3] * rstd) << 32);
                    *(LAS u64*)(ost + (32 * i + b) * OROW + (32 * nt + 8 * rg + 4 * hi) * 2) = w;
                }
        }
        asm volatile("s_waitcnt lgkmcnt(0)" ::: "memory");
#pragma unroll
        for (int k = 0; k < 8; ++k) {
            const int rowl = (lane >> 3) + 8 * k, chunk = lane & 7; const size_t tok = (size_t)(q0 + rowl);
            const u32x4 v = *(const LAS u32x4*)(ost + rowl * OROW + chunk * 16);
            const u32x4 z = *(const u32x4*)(AZ + tok * 512 + hq * 64 + chunk * 8);
            u32x4 w;
            w.x = cvt_pk_bf16(bflo(v.x) * bflo(z.x), bfhi(v.x) * bfhi(z.x)); w.y = cvt_pk_bf16(bflo(v.y) * bflo(z.y), bfhi(v.y) * bfhi(z.y));
            w.z = cvt_pk_bf16(bflo(v.z) * bflo(z.z), bfhi(v.z) * bfhi(z.z)); w.w = cvt_pk_bf16(bflo(v.w) * bflo(z.w), bfhi(v.w) * bfhi(z.w));
            *(u32x4*)(MIX + tok * 1024 + 512 + hq * 64 + chunk * 8) = w;
        }
        asm volatile("s_waitcnt lgkmcnt(0)" ::: "memory");
    }
}
}

__device__ __forceinline__ void final_phase(int wave, int lane, int G) {
    const KA a; const float* rsq2 = (const float*)(a.ws() + OFF_RSQ2); const float* fw = a.in(19); float* outp = a.out();
    f32x4 w[4];
#pragma unroll
    for (int j = 0; j < 4; ++j) w[j] = *(const f32x4*)(fw + j * 256 + lane * 4);
    for (int t = blockIdx.x * 8 + wave; t < M_TOK; t += G * 8) {
        const float rs = rsqrtf(rsq2[t] * (1.0f / DM) + RMS_EPS);
        float* o = outp + (size_t)t * DM;
#pragma unroll
        for (int j = 0; j < 4; ++j) { f32x4 v = *(const f32x4*)(o + j * 256 + lane * 4); v = v * w[j] * rs; *(f32x4*)(o + j * 256 + lane * 4) = v; }
    }
}

constexpr int LDS_BYTES = 147456;
__global__ void __launch_bounds__(512, 2) mega_fwd(Args a_unused) {
    extern __shared__ __attribute__((aligned(16))) unsigned char lds_raw[];
    LAS unsigned char* lds = (LAS unsigned char*)lds_raw;
    cg::grid_group grid = cg::this_grid();
#define WAVE_ID __builtin_amdgcn_readfirstlane(threadIdx.x >> 6)
#define LANE_ID ((int)(threadIdx.x & 63))
#define GRID_N ((int)gridDim.x)

    p0_prologue(lds, WAVE_ID, LANE_ID, GRID_N);
    grid.sync();
    {
        const KA a; unsigned char* ws = a.ws();
        pg8::Gemm g{(const bf16_t*)(ws + OFF_A), (const bf16_t*)(ws + OFF_WIN), M_TOK, NPROJ, DM}; pg8::StaticOrder S; S.init(M_TOK, NPROJ, GRID_N, (int)blockIdx.x);
        pg8::EpiIn E{(bf16_t*)(ws + OFF_UGM), (bf16_t*)(ws + OFF_SZ), (bf16_t*)(ws + OFF_Q), (bf16_t*)(ws + OFF_KB), (bf16_t*)(ws + OFF_VT), (bf16_t*)(ws + OFF_AZ)};
        pg8::gemm_phase<pg8::EpiIn, pg8::StaticOrder, true, true>(lds, g, S, E);
    }
    grid.sync();
    ssm_naive_phase(1, WAVE_ID, LANE_ID, GRID_N);
    grid.sync();
    ssm_naive_phase(0, WAVE_ID, LANE_ID, GRID_N);
    grid.sync();
    att::phase(lds, GRID_N);
    grid.sync();
    {
        const KA a; unsigned char* ws = a.ws();
        pg8::Gemm g{(const bf16_t*)(ws + OFF_G), (const bf16_t*)(ws + OFF_WGLU), M_TOK, 512, 512}; pg8::StaticOrder S; S.init(M_TOK, 512, GRID_N, (int)blockIdx.x);
        pg8::EpiGlu E{(const bf16_t*)(ws + OFF_G), (const bf16_t*)(ws + OFF_SZ), a.in(13), (bf16_t*)(ws + OFF_A), (float*)(ws + OFF_RSQ1)};
        pg8::gemm_phase<pg8::EpiGlu, pg8::StaticOrder, true, true>(lds, g, S, E);
    }
    grid.sync();
    {
        const KA a; unsigned char* ws = a.ws();
        pg8::Gemm g{(const bf16_t*)(ws + OFF_A), (const bf16_t*)(ws + OFF_WOUT), M_TOK, DM, DM}; pg8::StaticOrder S; S.init(M_TOK, DM, GRID_N, (int)blockIdx.x);
        pg8::EpiOut E{a.in(0), a.in(1), a.out(), (const float*)(ws + OFF_RSQ1), (float*)(ws + OFF_RSQ2)};
        pg8::gemm_phase<pg8::EpiOut, pg8::StaticOrder, true, true>(lds, g, S, E);
    }
    grid.sync();
    final_phase(WAVE_ID, LANE_ID, GRID_N);
}

extern "C" void kernel_launch(void* const* d_in, const int* in_sizes, int n_in, void* d_out, int out_size, void* d_ws, size_t ws_size, hipStream_t stream) {
    (void)in_sizes; (void)out_size;
    static int grid = 0;
    if (grid == 0) {
        if (n_in != 20 || ws_size < OFF_END) { fprintf(stderr, "kernel_launch: bad arguments (n_in %d, ws %zu < %zu)\n", n_in, ws_size, (size_t)OFF_END); grid = -1; return; }
        int dev = 0, cus = 0, per_cu = 0;
        if (hipGetDevice(&dev) != hipSuccess || hipDeviceGetAttribute(&cus, hipDeviceAttributeMultiprocessorCount, dev) != hipSuccess) { grid = -1; return; }
        if (hipFuncSetAttribute((const void*)mega_fwd, hipFuncAttributeMaxDynamicSharedMemorySize, LDS_BYTES) != hipSuccess) { fprintf(stderr, "kernel_launch: hipFuncSetAttribute failed\n"); grid = -1; return; }
        if (hipOccupancyMaxActiveBlocksPerMultiprocessor(&per_cu, (const void*)mega_fwd, 512, LDS_BYTES) != hipSuccess || per_cu < 1) { fprintf(stderr, "kernel_launch: occupancy query says %d\n", per_cu); grid = -1; return; }
        grid = cus * per_cu;
    }
    if (grid < 0) return;
    Args a{};
    for (int i = 0; i < 20; ++i) a.in[i] = (const float*)d_in[i];
    a.out = (float*)d_out; a.ws = (unsigned char*)d_ws;
    void* args[] = {&a};
    hipError_t e = hipLaunchCooperativeKernel((const void*)mega_fwd, dim3(grid), dim3(512), args, LDS_BYTES, stream);
    if (e != hipSuccess) fprintf(stderr, "cooperative launch failed: %s (grid %d)\n", hipGetErrorString(e), grid);
}
```

```cpp
#include <hip/hip_runtime.h>
#include <hip/hip_cooperative_groups.h>
#include <stdint.h>
#include <stdio.h>
namespace cg = cooperative_groups;

typedef unsigned short bf16_t;
typedef short bf16x8 __attribute__((ext_vector_type(8)));
typedef float f32x16 __attribute__((ext_vector_type(16)));
typedef float f32x4 __attribute__((ext_vector_type(4)));
typedef unsigned u32x4 __attribute__((ext_vector_type(4)));
#define LAS __attribute__((address_space(3)))

constexpr int M_TOK = 131072;
constexpr int M_PROMPT = 65536;
constexpr int DM = 1024;
constexpr int NPROJ = 2304;
constexpr float RMS_EPS = 1e-6f;

__device__ __forceinline__ bf16_t f2bf(float f) { uint32_t u = __float_as_uint(f); u += 0x7fffu + ((u >> 16) & 1u); return (bf16_t)(u >> 16); }
__device__ __forceinline__ float bf2f(bf16_t b) { return __uint_as_float(((uint32_t)b) << 16); }
__device__ __forceinline__ float bflo(unsigned w) { return __uint_as_float(w << 16); }
__device__ __forceinline__ float bfhi(unsigned w) { return __uint_as_float(w & 0xffff0000u); }
__device__ __forceinline__ unsigned cvt_pk_bf16(float lo, float hi) { unsigned r; asm volatile("v_cvt_pk_bf16_f32 %0, %1, %2" : "=v"(r) : "v"(lo), "v"(hi)); return r; }
__device__ __forceinline__ float silu_f(float v) { return v * __builtin_amdgcn_rcpf(1.0f + __expf(-v)); }
__device__ __forceinline__ float sigmoid_f(float v) { return __builtin_amdgcn_rcpf(1.0f + __expf(-v)); }
__device__ __forceinline__ float gelu_tanh_f(float x) { const float u = 0.7978845608028654f * (x + 0.044715f * x * x * x); return 0.5f * x * (1.0f + tanhf(u)); }
__device__ __forceinline__ void tok_seq(int t, int& start, int& len) {
    if (t < M_PROMPT) { len = 2048; start = t & ~2047; } else { len = 4096; start = M_PROMPT + ((t - M_PROMPT) & ~4095); }
}

constexpr size_t MiB = 1024 * 1024;
constexpr size_t OFF_A    = 0;
constexpr size_t OFF_UGM  = 256 * MiB;
constexpr size_t OFF_SZ   = OFF_UGM + 128 * MiB;
constexpr size_t OFF_Q    = OFF_SZ + 128 * MiB;
constexpr size_t OFF_KB   = OFF_Q + 128 * MiB;
constexpr size_t OFF_VT   = OFF_KB + 32 * MiB;
constexpr size_t OFF_AZ   = OFF_VT + 32 * MiB;
constexpr size_t OFF_G    = OFF_AZ + 128 * MiB;
constexpr size_t OFF_WIN  = OFF_G + 128 * MiB;
constexpr size_t OFF_WGLU = OFF_WIN + 5 * MiB;
constexpr size_t OFF_WOUT = OFF_WGLU + 1 * MiB;
constexpr size_t OFF_RSQ1 = OFF_WOUT + 2 * MiB;
constexpr size_t OFF_RSQ2 = OFF_RSQ1 + 512 * 1024;
constexpr size_t OFF_SSMT = OFF_RSQ2 + 512 * 1024;
constexpr size_t OFF_SSMW = OFF_SSMT + 4 * MiB;
constexpr size_t OFF_END  = OFF_SSMW + 32 * MiB;

namespace pg8 {
#define PG8_LAS __attribute__((address_space(3)))
typedef unsigned short bf16_t;
typedef short bf16x8 __attribute__((ext_vector_type(8)));
typedef float f32x4 __attribute__((ext_vector_type(4)));
typedef unsigned u32x4 __attribute__((ext_vector_type(4)));
constexpr int BM = 256, BK = 64, HALF = 128, HTB = HALF * BK * 2  , STAGE_BYTES = 8 * HTB, NXCD = 8, WGM = 8;

__host__ __device__ __forceinline__ int lds_byte(int r, int c) { const int st = (r >> 4) * 2 + (c >> 5), rr = r & 15, cc = c & 31, ob = rr * 64 + cc * 2; return st * 1024 + (ob ^ (((ob >> 9) & 1) << 5)); }
__host__ __device__ __forceinline__ void stage_rc(int b, int& R, int& C) { const int st = b / 1024, sb = b % 1024, swz = sb ^ (((sb >> 9) & 1) << 5); R = (st >> 1) * 16 + swz / 64; C = (st & 1) * 32 + (swz % 64) / 2; }
__host__ __device__ __forceinline__ int perm32(int rho) { const int n = rho >> 4, i = rho & 15; return 8 * (i >> 2) + 4 * n + (i & 3); }

struct Unit { int pm, pn; };
struct Gemm { const bf16_t* A; const bf16_t* Bt; int M, N, K; };

struct StaticOrder {
    int nM, nN, nwg, G, c;
    __host__ __device__ void init(int M, int N, int G_, int c_) { nM = M / BM; nN = N / BM; nwg = nM * nN; G = G_; c = c_; }
    __host__ __device__ bool next(int i, Unit& u) const {
        const long L = (long)i * G + c; if (L >= nwg) return false;
        int wgid = (int)L; { const int q = nwg / NXCD, r = nwg % NXCD, xcd = wgid % NXCD, off = wgid / NXCD; wgid = (xcd < r ? xcd * (q + 1) : r * (q + 1) + (xcd - r) * q) + off; }
        const int nig = WGM * nN, gid = wgid / nig, fm = gid * WGM, gsz = (nM - fm) < WGM ? (nM - fm) : WGM;
        u.pm = fm + ((wgid % nig) % gsz); u.pn = (wgid % nig) / gsz; return true;
    }
    __device__ __forceinline__ void a_ready(const Unit&) const {}
    __device__ __forceinline__ void done(const Unit&) const {}
};


__device__ __forceinline__ u32x4 pack8(const f32x4 a, const f32x4 b) { u32x4 w; w.x = ::cvt_pk_bf16(a[0], a[1]); w.y = ::cvt_pk_bf16(a[2], a[3]); w.z = ::cvt_pk_bf16(b[0], b[1]); w.w = ::cvt_pk_bf16(b[2], b[3]); return w; }
__device__ __forceinline__ f32x4 silu4(const f32x4 v) { f32x4 r; r[0] = ::silu_f(v[0]); r[1] = ::silu_f(v[1]); r[2] = ::silu_f(v[2]); r[3] = ::silu_f(v[3]); return r; }

struct EpiIn {
    static constexpr bool PERM = true, AFTER_DRAIN = false, MIDK = false;
    bf16_t *Ugm, *SZ, *Q, *Kb, *Vt, *AZ;
    __device__ __forceinline__ void operator()(const f32x4 (&acc)[2][2][4][2], const Unit& u, int wr, int wc, int fr, int fq) const {
        asm volatile("" : "+v"(fr), "+v"(fq));
        const int row0 = u.pm * BM + wr * 64 + fr, cl = wc * 32 + 8 * fq, pn = u.pn;
#pragma unroll
        for (int ai = 0; ai < 2; ++ai)
#pragma unroll
            for (int m = 0; m < 4; ++m) {
                const size_t row = (size_t)(row0 + ai * HALF + m * 16);
#pragma unroll
                for (int bj = 0; bj < 2; ++bj) {
                    const f32x4 v0 = acc[ai][bj][m][0], v1 = acc[ai][bj][m][1];
                    const int c = pn * BM + bj * HALF + cl;
                    if (pn < 2) { *(u32x4*)(Ugm + ((size_t)(c >> 4) * M_TOK + row) * 16 + (c & 15)) = pack8(v0, v1); }
                    else if (pn < 4) { *(u32x4*)(SZ + row * 512 + (c - 512)) = pack8(silu4(v0), silu4(v1)); }
                    else if (pn < 6) { *(u32x4*)(Q + row * 512 + (c - 1024)) = pack8(v0 * 0.125f, v1 * 0.125f); }
                    else if (pn == 6) {
                        if (bj == 0) { *(u32x4*)(Kb + row * 128 + cl) = pack8(v0, v1); }
                        else {
                            bf16_t* vp = Vt + (size_t)cl * M_TOK + row;
#pragma unroll
                            for (int j = 0; j < 4; ++j) { vp[(size_t)j * M_TOK] = ::f2bf(v0[j]); vp[(size_t)(j + 4) * M_TOK] = ::f2bf(v1[j]); }
                        }
                    }
                    else { *(u32x4*)(AZ + row * 512 + (c - 1792)) = pack8(silu4(v0), silu4(v1)); }
                }
            }
    }
};

struct EpiGlu {
    static constexpr bool PERM = true, AFTER_DRAIN = false, MIDK = false;
    const bf16_t *G, *SZ; const float* b_glu; bf16_t* MIX; float* rsq1;
    __device__ __forceinline__ void operator()(const f32x4 (&acc)[2][2][4][2], const Unit& u, int wr, int wc, int fr, int fq) const {
        asm volatile("" : "+v"(fr), "+v"(fq));
        const int row0 = u.pm * BM + wr * 64 + fr, cl = wc * 32 + 8 * fq, pn = u.pn;
        f32x4 bv[2][2];
#pragma unroll
        for (int bj = 0; bj < 2; ++bj) { bv[bj][0] = *(const f32x4*)(b_glu + pn * BM + bj * HALF + cl); bv[bj][1] = *(const f32x4*)(b_glu + pn * BM + bj * HALF + cl + 4); }
#pragma unroll
        for (int ai = 0; ai < 2; ++ai)
#pragma unroll
            for (int m = 0; m < 4; ++m) {
                const size_t row = (size_t)(row0 + ai * HALF + m * 16);
                float sq = 0.f;
#pragma unroll
                for (int bj = 0; bj < 2; ++bj) {
                    const int c = pn * BM + bj * HALF + cl;
                    const u32x4 gw = *(const u32x4*)(G + row * 512 + c), zw = *(const u32x4*)(SZ + row * 512 + c);
                    const f32x4 a0 = acc[ai][bj][m][0] + bv[bj][0], a1 = acc[ai][bj][m][1] + bv[bj][1];
                    f32x4 g0, g1, z0, z1;
                    g0[0] = ::bflo(gw.x); g0[1] = ::bfhi(gw.x); g0[2] = ::bflo(gw.y); g0[3] = ::bfhi(gw.y); g1[0] = ::bflo(gw.z); g1[1] = ::bfhi(gw.z); g1[2] = ::bflo(gw.w); g1[3] = ::bfhi(gw.w);
                    z0[0] = ::bflo(zw.x); z0[1] = ::bfhi(zw.x); z0[2] = ::bflo(zw.y); z0[3] = ::bfhi(zw.y); z1[0] = ::bflo(zw.z); z1[1] = ::bfhi(zw.z); z1[2] = ::bflo(zw.w); z1[3] = ::bfhi(zw.w);
                    f32x4 v0, v1;
#pragma unroll
                    for (int j = 0; j < 4; ++j) { v0[j] = g0[j] * ::sigmoid_f(a0[j]); v1[j] = g1[j] * ::sigmoid_f(a1[j]); sq += v0[j] * v0[j] + v1[j] * v1[j]; }
                    *(u32x4*)(MIX + row * 1024 + c) = pack8(v0 * z0, v1 * z1);
                }
                sq += __shfl_xor(sq, 16); sq += __shfl_xor(sq, 32);
                if (fq == 0) atomicAdd(rsq1 + row, sq);
                if (m & 1) asm volatile("" ::: "memory");
            }
    }
};

struct EpiOut {
    static constexpr bool PERM = false, AFTER_DRAIN = false, MIDK = true;
    const float *xp, *xs; float* out; const float* rsq1; float* rsq2;
    __device__ __forceinline__ void mid(f32x4 (&acc)[2][2][4][2], const Unit& u, int wr, int wc, int fr, int fq) const {
        asm volatile("" : "+v"(fr));
#pragma unroll
        for (int ai = 0; ai < 2; ++ai)
#pragma unroll
            for (int m = 0; m < 4; ++m) {
                const int row = u.pm * BM + ai * HALF + wr * 64 + m * 16 + fr;
                const float rs = rsqrtf(rsq1[row] * (1.0f / 512.0f) + ::RMS_EPS);
#pragma unroll
                for (int bj = 0; bj < 2; ++bj)
#pragma unroll
                    for (int n = 0; n < 2; ++n) acc[ai][bj][m][n] = acc[ai][bj][m][n] * rs;
            }
    }
    __device__ __forceinline__ void operator()(const f32x4 (&acc)[2][2][4][2], const Unit& u, int wr, int wc, int fr, int fq) const {
        asm volatile("" : "+v"(fr), "+v"(fq));
        const int col0 = u.pn * BM + wc * 32 + 4 * fq, r0 = u.pm * BM;
        const float* xb = (r0 < ::M_PROMPT) ? xp + (size_t)r0 * 1024 : xs + (size_t)(r0 - ::M_PROMPT) * 1024;
        float* ob = out + (size_t)r0 * 1024;
#pragma unroll
        for (int ai = 0; ai < 2; ++ai)
#pragma unroll
            for (int m = 0; m < 4; ++m) {
                const int rl = ai * HALF + wr * 64 + m * 16 + fr;
                float sq = 0.f;
#pragma unroll
                for (int bj = 0; bj < 2; ++bj)
#pragma unroll
                    for (int n = 0; n < 2; ++n) {
                        const size_t off = (size_t)rl * 1024 + col0 + bj * HALF + n * 16;
                        const f32x4 r = *(const f32x4*)(xb + off) + acc[ai][bj][m][n];
                        *(f32x4*)(ob + off) = r;
                        sq += (r[0] * r[0] + r[1] * r[1]) + (r[2] * r[2] + r[3] * r[3]);
                    }
                sq += __shfl_xor(sq, 16); sq += __shfl_xor(sq, 32);
                if (fq == 0) atomicAdd(rsq2 + r0 + rl, sq);
                if (m & 1) asm volatile("" ::: "memory");
            }
    }
};

template <class Epi, class Sched, bool ALIGN_EPI = false, bool SP2 = false>
__device__ __forceinline__ void gemm_phase(PG8_LAS unsigned char* lds, const Gemm g, const Sched& S, const Epi& E) {
    const int tid = threadIdx.x, wid = __builtin_amdgcn_readfirstlane(tid >> 6), lane = tid & 63, wr = wid >> 2, wc = wid & 3, fr = lane & 15, fq = lane >> 4;
    const int K = g.K, nt = K / BK;
    unsigned voffA[2], voffB[2];
#pragma unroll
    for (int i = 0; i < 2; ++i) { int R, C; stage_rc(tid * 16 + i * 8192, R, C); const int Rb = Epi::PERM ? ((R & ~31) + perm32(R & 31)) : R;
        voffA[i] = (unsigned)(R * K + C) * 2u; voffB[i] = (unsigned)(Rb * K + C) * 2u; }
    const size_t kstep = (size_t)(BK * 2);
    const size_t hstep = (size_t)HALF * K * 2;
    const size_t tstep = 2 * hstep;
    const unsigned ldsw = (unsigned)wid * 1024u;
    const int aoff = lds_byte(wr * 64 + fr, fq * 8), boff = lds_byte(wc * 32 + fr, fq * 8);
#define PG8_SA(b, h) (((b) * 2 + (h)) * HTB)
#define PG8_SB(b, h) ((4 + (b) * 2 + (h)) * HTB)
#define PG8_STAGE(bufoff, gbase, voff) do { _Pragma("unroll") for (int _i = 0; _i < 2; ++_i) \
        __builtin_amdgcn_global_load_lds((const unsigned*)((const char*)(gbase) + (voff)[_i]), (PG8_LAS unsigned*)(lds + (bufoff) + ldsw + _i * 8192), 16, 0, 0); } while (0)
#define PG8_LDA(dst, b, h) do { _Pragma("unroll") for (int m = 0; m < 4; ++m) _Pragma("unroll") for (int k = 0; k < 2; ++k) dst[m][k] = *(const PG8_LAS bf16x8*)(lds + PG8_SA(b, h) + aoff + m * 2048 + k * 1024); } while (0)
#define PG8_LDB(dst, b, h) do { _Pragma("unroll") for (int n = 0; n < 2; ++n) _Pragma("unroll") for (int k = 0; k < 2; ++k) dst[n][k] = *(const PG8_LAS bf16x8*)(lds + PG8_SB(b, h) + boff + n * 2048 + k * 1024); } while (0)
#define PG8_MMA(ai, bj, At, Bt) do { __builtin_amdgcn_s_setprio(1); _Pragma("unroll") for (int m = 0; m < 4; ++m) _Pragma("unroll") for (int n = 0; n < 2; ++n) _Pragma("unroll") for (int k = 0; k < 2; ++k) \
        acc[ai][bj][m][n] = __builtin_amdgcn_mfma_f32_16x16x32_bf16(Bt[n][k], At[m][k], acc[ai][bj][m][n], 0, 0, 0); __builtin_amdgcn_s_setprio(0); } while (0)
#define PG8_WAIT_V(n) asm volatile("s_waitcnt vmcnt(" #n ")" ::: "memory")
#define PG8_WAIT_L(n) asm volatile("s_waitcnt lgkmcnt(" #n ")" ::: "memory")
#define PG8_BAR __builtin_amdgcn_s_barrier()
#define PG8_SCHED __builtin_amdgcn_sched_barrier(0)
    Unit cur, nxt; int ui = 0;
    if (!S.next(0, cur)) return;
    f32x4 acc[2][2][4][2];
#pragma unroll
    for (int a = 0; a < 2; ++a)
#pragma unroll
        for (int b = 0; b < 2; ++b)
#pragma unroll
            for (int m = 0; m < 4; ++m)
#pragma unroll
                for (int n = 0; n < 2; ++n) acc[a][b][m][n] = (f32x4){0.f, 0.f, 0.f, 0.f};
    bf16x8 At[4][2], B0[2][2], B1[2][2];
    const char* cA = (const char*)g.A + (size_t)cur.pm * tstep; const char* cB = (const char*)g.Bt + (size_t)cur.pn * tstep;
    S.a_ready(cur);
    if constexpr (SP2) {
        PG8_STAGE(PG8_SB(0, 0), cB, voffB); PG8_STAGE(PG8_SB(0, 1), cB + hstep, voffB); PG8_STAGE(PG8_SA(0, 0), cA, voffA); PG8_STAGE(PG8_SA(0, 1), cA + hstep, voffA);
        if (wr == 1) PG8_BAR;
        PG8_WAIT_V(2); PG8_BAR;
        PG8_STAGE(PG8_SB(1, 0), cB + kstep, voffB); PG8_STAGE(PG8_SA(1, 0), cA + kstep, voffA); PG8_STAGE(PG8_SB(1, 1), cB + hstep + kstep, voffB);
        PG8_WAIT_V(6); PG8_BAR;
    } else {
        PG8_STAGE(PG8_SB(0, 0), cB, voffB); PG8_STAGE(PG8_SA(0, 0), cA, voffA); PG8_STAGE(PG8_SB(0, 1), cB + hstep, voffB); PG8_STAGE(PG8_SA(0, 1), cA + hstep, voffA);
        if (wr == 1) PG8_BAR;
        PG8_WAIT_V(4); PG8_BAR;
        PG8_STAGE(PG8_SB(1, 0), cB + kstep, voffB); PG8_STAGE(PG8_SA(1, 0), cA + kstep, voffA); PG8_STAGE(PG8_SB(1, 1), cB + hstep + kstep, voffB);
        PG8_WAIT_V(6); PG8_BAR;
    }
    for (;;) {
        const bool has_next = S.next(ui + 1, nxt);
        const char* nA = has_next ? (const char*)g.A + (size_t)nxt.pm * tstep : cA; const char* nB = has_next ? (const char*)g.Bt + (size_t)nxt.pn * tstep : cB;
        for (int t = 0; t < nt; t += 2) {
            if constexpr (Epi::MIDK) { if (t == (nt >> 1)) E.mid(acc, cur, wr, wc, fr, fq); }
            const bool last = (t == nt - 2);
            const char* a1 = cA + (size_t)(t + 1) * kstep;
            const char* a2 = last ? nA : cA + (size_t)(t + 2) * kstep; const char* b2 = last ? nB : cB + (size_t)(t + 2) * kstep;
            const char* a3 = a2 + kstep; const char* b3 = b2 + kstep;
            if (last && has_next) S.a_ready(nxt);
            if constexpr (SP2) {
            PG8_LDB(B0, 0, 0); PG8_LDB(B1, 0, 1); PG8_SCHED; PG8_LDA(At, 0, 0); PG8_STAGE(PG8_SA(1, 1), a1 + hstep, voffA);
            PG8_WAIT_V(8); PG8_WAIT_L(0); PG8_BAR; PG8_MMA(0, 0, At, B0); PG8_MMA(0, 1, At, B1); PG8_BAR; PG8_SCHED;
            PG8_LDA(At, 0, 1); PG8_STAGE(PG8_SB(0, 0), b2, voffB); PG8_STAGE(PG8_SB(0, 1), b2 + hstep, voffB); PG8_STAGE(PG8_SA(0, 0), a2, voffA);
            PG8_WAIT_V(8); PG8_WAIT_L(0); PG8_BAR; PG8_MMA(1, 0, At, B0); PG8_MMA(1, 1, At, B1); PG8_BAR; PG8_SCHED;
            PG8_LDB(B0, 1, 0); PG8_LDB(B1, 1, 1); PG8_SCHED; PG8_LDA(At, 1, 0); PG8_STAGE(PG8_SA(0, 1), a2 + hstep, voffA);
            PG8_WAIT_V(8); PG8_WAIT_L(0); PG8_BAR; PG8_MMA(0, 0, At, B0); PG8_MMA(0, 1, At, B1); PG8_BAR; PG8_SCHED;
            PG8_LDA(At, 1, 1); PG8_STAGE(PG8_SB(1, 0), b3, voffB); PG8_STAGE(PG8_SB(1, 1), b3 + hstep, voffB); PG8_STAGE(PG8_SA(1, 0), a3, voffA);
            PG8_WAIT_V(8); PG8_WAIT_L(0); PG8_BAR; PG8_MMA(1, 0, At, B0); PG8_MMA(1, 1, At, B1); PG8_BAR; PG8_SCHED;
            } else {
            PG8_LDB(B0, 0, 0); PG8_SCHED; PG8_LDA(At, 0, 0); PG8_STAGE(PG8_SA(1, 1), a1 + hstep, voffA);
            PG8_WAIT_L(8); PG8_BAR; PG8_WAIT_L(0); PG8_MMA(0, 0, At, B0); PG8_BAR; PG8_SCHED;
            PG8_LDB(B1, 0, 1); PG8_STAGE(PG8_SB(0, 0), b2, voffB);
            PG8_BAR; PG8_WAIT_L(0); PG8_MMA(0, 1, At, B1); PG8_BAR;
            PG8_LDA(At, 0, 1); PG8_STAGE(PG8_SA(0, 0), a2, voffA);
            PG8_BAR; PG8_WAIT_L(0); PG8_MMA(1, 0, At, B0); PG8_BAR; PG8_SCHED;
            PG8_STAGE(PG8_SB(0, 1), b2 + hstep, voffB);
            PG8_WAIT_V(6); PG8_BAR; PG8_MMA(1, 1, At, B1); PG8_BAR;
            PG8_LDB(B0, 1, 0); PG8_SCHED; PG8_LDA(At, 1, 0); PG8_STAGE(PG8_SA(0, 1), a2 + hstep, voffA);
            PG8_WAIT_L(8); PG8_BAR; PG8_WAIT_L(0); PG8_MMA(0, 0, At, B0); PG8_BAR; PG8_SCHED;
            PG8_LDB(B1, 1, 1); PG8_STAGE(PG8_SB(1, 0), b3, voffB);
            PG8_BAR; PG8_WAIT_L(0); PG8_MMA(0, 1, At, B1); PG8_BAR;
            PG8_LDA(At, 1, 1); PG8_STAGE(PG8_SA(1, 0), a3, voffA);
            PG8_BAR; PG8_WAIT_L(0); PG8_MMA(1, 0, At, B0); PG8_BAR; PG8_SCHED;
            PG8_STAGE(PG8_SB(1, 1), b3 + hstep, voffB);
            PG8_WAIT_V(6); PG8_BAR; PG8_MMA(1, 1, At, B1); PG8_BAR;
            }
        }
        if constexpr (ALIGN_EPI) { if (wr == 0) PG8_BAR; }
        if constexpr (!Epi::AFTER_DRAIN) { E(acc, cur, wr, wc, fr, fq); S.done(cur); }
        if (!has_next) break;
#pragma unroll
        for (int a = 0; a < 2; ++a)
#pragma unroll
            for (int b = 0; b < 2; ++b)
#pragma unroll
                for (int m = 0; m < 4; ++m)
#pragma unroll
                    for (int n = 0; n < 2; ++n) acc[a][b][m][n] = (f32x4){0.f, 0.f, 0.f, 0.f};
        cur = nxt; cA = nA; cB = nB; ++ui;
        if constexpr (ALIGN_EPI) { if (wr == 1) PG8_BAR; }
    }
    PG8_WAIT_V(0);
    if constexpr (!ALIGN_EPI) { if (wr == 0) PG8_BAR; }
    PG8_BAR;
    if constexpr (Epi::AFTER_DRAIN) { E.fused(acc, cur, wr, wc, fr, fq, lds, wid, lane); S.done(cur); }
#undef PG8_SA
#undef PG8_SB
#undef PG8_STAGE
#undef PG8_LDA
#undef PG8_LDB
#undef PG8_MMA
#undef PG8_WAIT_V
#undef PG8_WAIT_L
#undef PG8_BAR
#undef PG8_SCHED
}
}

struct Args {
    const float* in[20];
    float* out; unsigned char* ws;
};
typedef const unsigned char __attribute__((address_space(4)))* kptr_t;
struct KA {
    kptr_t p;
    __device__ __forceinline__ KA() { p = (kptr_t)__builtin_amdgcn_kernarg_segment_ptr(); asm volatile("" : "+s"(p)); }
    __device__ __forceinline__ const float* in(int i) const { return *(const float* const __attribute__((address_space(4)))*)(p + 8 * i); }
    __device__ __forceinline__ float* out() const { return *(float* const __attribute__((address_space(4)))*)(p + 160); }
    __device__ __forceinline__ unsigned char* ws() const { return *(unsigned char* const __attribute__((address_space(4)))*)(p + 168); }
};

__device__ __forceinline__ float wave_sum(float v) {
#pragma unroll
    for (int o = 1; o < 64; o <<= 1) v += __shfl_xor(v, o);
    return v;
}

__device__ __forceinline__ void p0_transpose_item(const float* __restrict__ w, int K, int N, const float* __restrict__ s1, const float* __restrict__ s2, int ksplit, bf16_t* __restrict__ out,
                                                  LAS float* scr, int item, int lane) {
    const int nblk = N / 32, kb = item / nblk, nb = item % nblk, k0 = 32 * kb, n0 = 32 * nb;
#pragma unroll 4
    for (int i = 0; i < 16; ++i) {
        const int kk = 2 * i + (lane >> 5), k = k0 + kk; float sc = 1.0f;
        if (s1) sc = (k < ksplit) ? s1[k] : s2[k - ksplit];
        scr[kk * 33 + (lane & 31)] = w[(size_t)k * N + n0 + (lane & 31)] * sc;
    }
    asm volatile("s_waitcnt lgkmcnt(0)" ::: "memory");
#pragma unroll 4
    for (int j = 0; j < 16; ++j) { const int n = 2 * j + (lane >> 5), k = lane & 31; out[(size_t)(n0 + n) * K + k0 + k] = f2bf(scr[k * 33 + n]); }
    asm volatile("s_waitcnt lgkmcnt(0)" ::: "memory");
}

__device__ __forceinline__ void p0_prologue(LAS unsigned char* lds, int wave, int lane, int G) {
    const KA a; unsigned char* ws = a.ws();
    LAS float* scr = (LAS float*)(lds + wave * 4352);
    const int gw = blockIdx.x * 8 + wave, NGW = G * 8;
    constexpr int I_IN = (DM / 32) * (NPROJ / 32), I_GLU = 16 * 16, I_OUT = 32 * 32;
    for (int it = gw; it < I_IN + I_GLU + I_OUT; it += NGW) {
        int r = it;
        if (r < I_IN) { p0_transpose_item(a.in(3), DM, NPROJ, a.in(2), a.in(2), DM, (bf16_t*)(ws + OFF_WIN), scr, r, lane); continue; } r -= I_IN;
        if (r < I_GLU) { p0_transpose_item(a.in(12), 512, 512, nullptr, nullptr, 0, (bf16_t*)(ws + OFF_WGLU), scr, r, lane); continue; } r -= I_GLU;
        p0_transpose_item(a.in(17), DM, DM, a.in(14), a.in(16), 512, (bf16_t*)(ws + OFF_WOUT), scr, r, lane);
    }
    bf16_t* H = (bf16_t*)(ws + OFF_A);
    for (int t = gw; t < M_TOK; t += NGW) {
        const float* x = (t < M_PROMPT) ? a.in(0) + (size_t)t * DM : a.in(1) + (size_t)(t - M_PROMPT) * DM;
        f32x4 v[4]; float s = 0.f;
#pragma unroll
        for (int j = 0; j < 4; ++j) { v[j] = *(const f32x4*)(x + j * 256 + lane * 4); s += (v[j][0] * v[j][0] + v[j][1] * v[j][1]) + (v[j][2] * v[j][2] + v[j][3] * v[j][3]); }
        const float rs = rsqrtf(wave_sum(s) * (1.0f / DM) + RMS_EPS);
#pragma unroll
        for (int j = 0; j < 4; ++j) { uint2 w; w.x = cvt_pk_bf16(v[j][0] * rs, v[j][1] * rs); w.y = cvt_pk_bf16(v[j][2] * rs, v[j][3] * rs); *(uint2*)(H + (size_t)t * DM + j * 256 + lane * 4) = w; }
    }
    float* rsq = (float*)(ws + OFF_RSQ1);
    for (int i = blockIdx.x * 512 + threadIdx.x; i < 2 * M_TOK; i += G * 512) rsq[i] = 0.f;
}

__device__ __forceinline__ int t5_bucket(int rel) {
    const int n = rel < 0 ? -rel : rel; int b = rel > 0 ? 16 : 0;
    if (n < 8) return b + n;
    const float nf = (float)n;
    int large = 8 + (int)(logf(nf / 8.0f) / 2.772588722239781f * 8.0f);
    if (large > 15) large = 15;
    return b + large;
}
namespace att {
constexpr int L_BIAS = 0, L_K = 10240, L_VT = 28672, L_SSQ = 47104, L_OST = 49152;
constexpr int KROW = 144, VROW = 72, OROW = 144, KBUF = 9216, VBUF = 9216;
typedef unsigned long long u64;

__device__ __forceinline__ void tile(const LAS unsigned char* kb, const LAS unsigned char* vb, const LAS float* btw, const bf16x8 (&q)[4], f32x16& o0, f32x16& o1, float& m, float& l, int delta, int b, int hi) {
    f32x16 p;
#pragma unroll
    for (int r = 0; r < 16; ++r) p[r] = 0.f;
#pragma unroll
    for (int s = 0; s < 4; ++s) { const bf16x8 kf = *(const LAS bf16x8*)(kb + b * KROW + s * 32 + hi * 16); p = __builtin_amdgcn_mfma_f32_32x32x16_bf16(kf, q[s], p, 0, 0, 0); }
    const LAS float* bp = btw + (32 * delta + 32 + 4 * hi - b);
#pragma unroll
    for (int r = 0; r < 16; ++r) p[r] += bp[(r & 3) + 8 * (r >> 2)];
    if (delta == 0) {
#pragma unroll
        for (int r = 0; r < 16; ++r) { const int aa = (r & 3) + 8 * (r >> 2) + 4 * hi; if (aa < b) p[r] = -1e30f; }
    } else if (delta == 8) {
#pragma unroll
        for (int r = 0; r < 16; ++r) { const int aa = (r & 3) + 8 * (r >> 2) + 4 * hi; if (aa > b) p[r] = -1e30f; }
    }
    float tm = p[0];
#pragma unroll
    for (int r = 1; r < 16; ++r) tm = fmaxf(tm, p[r]);
    tm = fmaxf(tm, __shfl_xor(tm, 32));
    const float mn = fmaxf(m, tm), alpha = __expf(m - mn);
    m = mn;
    float rs = 0.f;
#pragma unroll
    for (int r = 0; r < 16; ++r) { p[r] = __expf(p[r] - mn); rs += p[r]; }
    l = l * alpha + rs;
    o0 = o0 * alpha; o1 = o1 * alpha;
    bf16x8 pf[2];
#pragma unroll
    for (int s = 0; s < 2; ++s) {
        u32x4 w; w.x = cvt_pk_bf16(p[8 * s + 0], p[8 * s + 1]); w.y = cvt_pk_bf16(p[8 * s + 2], p[8 * s + 3]); w.z = cvt_pk_bf16(p[8 * s + 4], p[8 * s + 5]); w.w = cvt_pk_bf16(p[8 * s + 6], p[8 * s + 7]);
        pf[s] = __builtin_bit_cast(bf16x8, w);
    }
#pragma unroll
    for (int s = 0; s < 2; ++s) {
        { const LAS unsigned char* vp = vb + b * VROW + 32 * s + 8 * hi; const u64 lo = *(const LAS u64*)vp, hh = *(const LAS u64*)(vp + 16);
          typedef u64 u64x2 __attribute__((ext_vector_type(2))); u64x2 t; t.x = lo; t.y = hh; o0 = __builtin_amdgcn_mfma_f32_32x32x16_bf16(__builtin_bit_cast(bf16x8, t), pf[s], o0, 0, 0, 0); }
        { const LAS unsigned char* vp = vb + (32 + b) * VROW + 32 * s + 8 * hi; const u64 lo = *(const LAS u64*)vp, hh = *(const LAS u64*)(vp + 16);
          typedef u64 u64x2 __attribute__((ext_vector_type(2))); u64x2 t; t.x = lo; t.y = hh; o1 = __builtin_amdgcn_mfma_f32_32x32x16_bf16(__builtin_bit_cast(bf16x8, t), pf[s], o1, 0, 0, 0); }
    }
}

__device__ __forceinline__ void phase(LAS unsigned char* lds, int G) {
    const KA a; unsigned char* ws = a.ws();
    const bf16_t* Q = (const bf16_t*)(ws + OFF_Q); const bf16_t* Kb = (const bf16_t*)(ws + OFF_KB); const bf16_t* Vt = (const bf16_t*)(ws + OFF_VT); const bf16_t* AZ = (const bf16_t*)(ws + OFF_AZ);
    bf16_t* MIX = (bf16_t*)(ws + OFF_A);
    const int tid = threadIdx.x, lane = tid & 63, hq = __builtin_amdgcn_readfirstlane(tid >> 6), kvh = hq >> 2, b = lane & 31, hi = lane >> 5;
    {
        const float* rel_bias = a.in(18);
        LAS float* bt = (LAS float*)(lds + L_BIAS);
        for (int e = tid; e < 8 * 320; e += 512) { const int h = e / 320, rel = (e % 320) - 160; bt[e] = (rel >= -128 && rel <= 128) ? rel_bias[t5_bucket(rel) * 8 + h] : 0.f; }
    }
    const float sinkv = a.in(15)[hq];
    const LAS float* btw = (const LAS float*)(lds + L_BIAS) + hq * 320;
    LAS float* ssq = (LAS float*)(lds + L_SSQ);
    LAS unsigned char* ost = lds + L_OST + hq * (64 * OROW);
    const int kkey = tid >> 4, kchunk = tid & 15, vch = tid >> 2, vpart = tid & 3;
    const int kl = (kchunk >> 3) * (32 * KROW) + kkey * KROW + (kchunk & 7) * 16;
    const int vl = (vch >> 6) * (64 * VROW) + (vch & 63) * VROW + vpart * 16;
    for (int item = blockIdx.x; item < M_TOK / 64; item += G) {
        const int q0 = item * 64; int start, len; tok_seq(q0, start, len); const int end = start + len;
        bf16x8 qf[2][4];
#pragma unroll
        for (int i = 0; i < 2; ++i)
#pragma unroll
            for (int s = 0; s < 4; ++s) qf[i][s] = *(const bf16x8*)(Q + (size_t)(q0 + 32 * i + b) * 512 + hq * 64 + 16 * s + 8 * hi);
        f32x16 o[2][2]; float m[2], l[2];
#pragma unroll
        for (int i = 0; i < 2; ++i) { m[i] = sinkv; l[i] = hi ? 0.f : 1.f;
#pragma unroll
            for (int r = 0; r < 16; ++r) { o[i][0][r] = 0.f; o[i][1][r] = 0.f; } }
        u32x4 kreg, vreg;
        { const int ks = q0 - 128; if (ks >= start && ks < end) { kreg = *(const u32x4*)(Kb + (size_t)(ks + kkey) * 128 + kchunk * 8); vreg = *(const u32x4*)(Vt + (size_t)vch * M_TOK + ks + vpart * 8); } }
        for (int j = 0; j < 10; ++j) {
            const int ks = q0 - 128 + 32 * j; const bool valid = (ks >= start && ks < end);
            const int buf = j & 1;
            if (valid) {
                *(LAS u32x4*)(lds + L_K + buf * KBUF + kl) = kreg;
                typedef u64 u64x2 __attribute__((ext_vector_type(2))); const u64x2 vv = __builtin_bit_cast(u64x2, vreg);
                *(LAS u64*)(lds + L_VT + buf * VBUF + vl) = vv.x; *(LAS u64*)(lds + L_VT + buf * VBUF + vl + 8) = vv.y;
            }
            { const int kn = ks + 32; if (j < 9 && kn >= start && kn < end) { kreg = *(const u32x4*)(Kb + (size_t)(kn + kkey) * 128 + kchunk * 8); vreg = *(const u32x4*)(Vt + (size_t)vch * M_TOK + kn + vpart * 8); } }
            __syncthreads();
            if (valid) {
                const LAS unsigned char* kb = lds + L_K + buf * KBUF + kvh * (32 * KROW);
                const LAS unsigned char* vb = lds + L_VT + buf * VBUF + kvh * (64 * VROW);
                if (j <= 8) tile(kb, vb, btw, qf[0], o[0][0], o[0][1], m[0], l[0], j, b, hi);
                if (j >= 1) tile(kb, vb, btw, qf[1], o[1][0], o[1][1], m[1], l[1], j - 1, b, hi);
            }
        }
#pragma unroll
        for (int i = 0; i < 2; ++i) {
            const float lt = l[i] + __shfl_xor(l[i], 32), inv = 1.0f / lt;
            float ss = 0.f;
#pragma unroll
            for (int r = 0; r < 16; ++r) { o[i][0][r] *= inv; o[i][1][r] *= inv; ss += o[i][0][r] * o[i][0][r] + o[i][1][r] * o[i][1][r]; }
            ss += __shfl_xor(ss, 32);
            if (hi == 0) ssq[(32 * i + b) * 8 + hq] = ss;
        }
        __syncthreads();
#pragma unroll
        for (int i = 0; i < 2; ++i) {
            const f32x4 s0 = *(const LAS f32x4*)(ssq + (32 * i + b) * 8), s1 = *(const LAS f32x4*)(ssq + (32 * i + b) * 8 + 4);
            const float tot = ((s0[0] + s0[1]) + (s0[2] + s0[3])) + ((s1[0] + s1[1]) + (s1[2] + s1[3]));
            const float rstd = rsqrtf(tot * (1.0f / 512.0f) + RMS_EPS);
#pragma unroll
            for (int nt = 0; nt < 2; ++nt)
#pragma unroll
                for (int rg = 0; rg < 4; ++rg) {
                    const u64 w = (u64)cvt_pk_bf16(o[i][nt][4 * rg] * rstd, o[i][nt][4 * rg + 1] * rstd) | ((u64)cvt_pk_bf16(o[i][nt][4 * rg + 2] * rstd, o[i][nt][4 * rg + 3] * rstd) << 32);
                    *(LAS u64*)(ost + (32 * i + b) * OROW + (32 * nt + 8 * rg + 4 * hi) * 2) = w;
                }
        }
        asm volatile("s_waitcnt lgkmcnt(0)" ::: "memory");
#pragma unroll
        for (int k = 0; k < 8; ++k) {
            const int rowl = (lane >> 3) + 8 * k, chunk = lane & 7; const size_t tok = (size_t)(q0 + rowl);
            const u32x4 v = *(const LAS u32x4*)(ost + rowl * OROW + chunk * 16);
            const u32x4 z = *(const u32x4*)(AZ + tok * 512 + hq * 64 + chunk * 8);
            u32x4 w;
            w.x = cvt_pk_bf16(bflo(v.x) * bflo(z.x), bfhi(v.x) * bfhi(z.x)); w.y = cvt_pk_bf16(bflo(v.y) * bflo(z.y), bfhi(v.y) * bfhi(z.y));
            w.z = cvt_pk_bf16(bflo(v.z) * bflo(z.z), bfhi(v.z) * bfhi(z.z)); w.w = cvt_pk_bf16(bflo(v.w) * bflo(z.w), bfhi(v.w) * bfhi(z.w));
            *(u32x4*)(MIX + tok * 1024 + 512 + hq * 64 + chunk * 8) = w;
        }
        asm volatile("s_waitcnt lgkmcnt(0)" ::: "memory");
    }
}
}


namespace ssm {
typedef float f32x2 __attribute__((ext_vector_type(2)));
typedef unsigned long long u64;
constexpr size_t GRP_T = 128 * 1024;
constexpr int T_APOW = 0, T_BBAR = 2 * 33 * 64 * 8, T_KTAB = T_BBAR + 2 * 64 * 16 * 8;
constexpr size_t GRP_W = 1024 * 1024; constexpr int W_1 = 0, W_2 = 256 * 1024;
static_assert(T_KTAB + 2 * 32 * 256 * 4 <= (int)GRP_T, "group table");

__device__ __forceinline__ void stage_a(LAS unsigned char* lds, int G) {
    const KA a; unsigned char* ws = a.ws();
    const float* lam_re = a.in(4); const float* lam_im = a.in(5); const float* log_step = a.in(6);
    const float* b_re = a.in(7); const float* b_im = a.in(8); const float* c_re = a.in(9); const float* c_im = a.in(10);
    LAS f32x2* l_apow = (LAS f32x2*)lds;
    LAS f32x2* l_coef = l_apow + 33 * 64;
    LAS f32x2* l_bbar = l_coef + 64;
    LAS f32x2* l_c = l_bbar + 1024;
    const int tid = threadIdx.x;
    for (int item = blockIdx.x; item < 256; item += G) {
        const int g = item >> 3, dir = (item >> 2) & 1, oct = item & 3, pg = dir * 32 + g;
        {
            const int p = tid & 63, tg = tid >> 6;
            const float lr = lam_re[pg * 64 + p], li = lam_im[pg * 64 + p], dt = expf(log_step[pg]);
            const float ang = li * dt, dec = lr * dt;
            for (int tau = tg; tau <= 32; tau += 8) {
                const float mag = expf(dec * (float)tau); float sn, cs; sincosf(ang * (float)tau, &sn, &cs);
                f32x2 v; v.x = mag * cs; v.y = mag * sn; l_apow[tau * 64 + p] = v;
            }
            if (tg == 0) {
                const float mag = expf(dec); float sn, cs; sincosf(ang, &sn, &cs);
                const float are = mag * cs, aim = mag * sn, den = lr * lr + li * li, nr = are - 1.0f;
                f32x2 v; v.x = (nr * lr + aim * li) / den; v.y = (aim * lr - nr * li) / den; l_coef[p] = v;
            }
        }
        __syncthreads();
        for (int e = tid; e < 1024; e += 512) {
            const int p = e >> 4, h = e & 15; const float br = b_re[(pg * 64 + p) * 16 + h], bi = b_im[(pg * 64 + p) * 16 + h]; const f32x2 co = l_coef[p];
            f32x2 v; v.x = co.x * br - co.y * bi; v.y = co.x * bi + co.y * br; l_bbar[e] = v;
        }
        for (int e = tid; e < 1024; e += 512) { const int h = e >> 6, p = e & 63; f32x2 v; v.x = c_re[(pg * 16 + h) * 64 + p]; v.y = c_im[(pg * 16 + h) * 64 + p]; l_c[e] = v; }
        __syncthreads();
        unsigned char* gt = ws + OFF_SSMT + (size_t)g * GRP_T;
        if (oct == 0) {
            f32x2* d_apow = (f32x2*)(gt + T_APOW) + dir * 33 * 64; f32x2* d_bbar = (f32x2*)(gt + T_BBAR) + dir * 1024;
            for (int e = tid; e < 33 * 64; e += 512) d_apow[e] = l_apow[e];
            for (int e = tid; e < 1024; e += 512) d_bbar[e] = l_bbar[e];
        }
        {
            const int tau = 8 * oct + (tid >> 6), h = (tid >> 2) & 15, hq4 = tid & 3;
            float acc[4] = {0.f, 0.f, 0.f, 0.f};
            for (int p = 0; p < 64; ++p) {
                const f32x2 cc = l_c[h * 64 + p], ap = l_apow[tau * 64 + p];
                const float ca_re = cc.x * ap.x - cc.y * ap.y, ca_im = cc.x * ap.y + cc.y * ap.x;
#pragma unroll
                for (int i = 0; i < 4; ++i) { const f32x2 bb = l_bbar[p * 16 + 4 * hq4 + i]; acc[i] += ca_re * bb.x - ca_im * bb.y; }
            }
            float* d_k = (float*)(gt + T_KTAB) + ((dir * 32 + tau) * 16 + h) * 16 + 4 * hq4;
            f32x4 o; o[0] = acc[0]; o[1] = acc[1]; o[2] = acc[2]; o[3] = acc[3]; *(f32x4*)d_k = o;
        }
        __syncthreads();
    }
}

__device__ __forceinline__ void stage_b(LAS unsigned char* lds, int G) {
    const KA a; unsigned char* ws = a.ws();
    const float* c_re = a.in(9); const float* c_im = a.in(10); const float* d_skip = a.in(11);
    LAS f32x2* l_apow = (LAS f32x2*)lds;
    LAS f32x2* l_bbar = l_apow + 2 * 33 * 64;
    LAS f32x2* l_c = l_bbar + 2 * 1024;
    LAS float* l_k = (LAS float*)(l_c + 2 * 1024);
    LAS float* l_d = l_k + 2 * 32 * 256;
    const int tid = threadIdx.x;
    for (int item = blockIdx.x; item < 256; item += G) {
        const int g = item >> 3, sub = item & 7;
        const unsigned char* gt = ws + OFF_SSMT + (size_t)g * GRP_T;
        for (int e = tid; e < (T_KTAB) / 16; e += 512) ((LAS u32x4*)l_apow)[e] = ((const u32x4*)gt)[e];
        for (int e = tid; e < 2 * 32 * 256 / 4; e += 512) ((LAS u32x4*)l_k)[e] = ((const u32x4*)(gt + T_KTAB))[e];
        for (int e = tid; e < 2048; e += 512) { const int dir = e >> 10, h = (e >> 6) & 15, p = e & 63; f32x2 v; v.x = c_re[((dir * 32 + g) * 16 + h) * 64 + p]; v.y = c_im[((dir * 32 + g) * 16 + h) * 64 + p]; l_c[e] = v; }
        if (tid < 16) l_d[tid] = d_skip[g * 16 + tid];
        __syncthreads();
        unsigned char* gw = ws + OFF_SSMW + (size_t)g * GRP_W;
#pragma unroll 1
        for (int i = 0; i < 4; ++i) {
            const int idx = tid + 512 * i, ks = idx >> 6, ln = idx & 63, n_l = ln & 31, hL = ln >> 5;
            const int n = 32 * sub + n_l, d = n >> 7, ri = (n >> 6) & 1, p = n & 63, tau = d ? ks : 31 - ks;
            const f32x2 ap = l_apow[(d * 33 + tau) * 64 + p];
            float v[8];
#pragma unroll
            for (int jj = 0; jj < 8; ++jj) { const f32x2 bb = l_bbar[(d * 64 + p) * 16 + 8 * hL + jj]; v[jj] = ri ? (ap.x * bb.y + ap.y * bb.x) : (ap.x * bb.x - ap.y * bb.y); }
            u32x4 w; w.x = cvt_pk_bf16(v[0], v[1]); w.y = cvt_pk_bf16(v[2], v[3]); w.z = cvt_pk_bf16(v[4], v[5]); w.w = cvt_pk_bf16(v[6], v[7]);
            *(u32x4*)(gw + W_1 + ((size_t)(ks * 8 + sub) * 64 + ln) * 16) = w;
        }
#pragma unroll 1
        for (int i = 0; i < 12; ++i) {
            const int idx = tid + 512 * i, nt2 = idx / 3072, rem = idx - nt2 * 3072, ks = rem >> 6, ln = rem & 63, n_l = ln & 31, hL = ln >> 5;
            const int nt = 2 * sub + nt2, n2 = 32 * nt + n_l, kt = n2 >> 4, hh = n2 & 15;
            float v[8];
            if (ks < 32) {
                const int j = ks;
#pragma unroll
                for (int jj = 0; jj < 8; ++jj) {
                    const int hp = 8 * hL + jj; float x = 0.f;
                    if (j <= kt) x += l_k[((kt - j) * 16 + hh) * 16 + hp];
                    if (j >= kt) x += l_k[((32 + j - kt) * 16 + hh) * 16 + hp];
                    if (j == kt && hh == hp) x += l_d[hh];
                    v[jj] = x;
                }
            } else {
#pragma unroll
                for (int jj = 0; jj < 8; ++jj) {
                    const int n = 16 * (ks - 32) + 8 * hL + jj, d = n >> 7, ri = (n >> 6) & 1, p = n & 63, tau = d ? 32 - kt : kt + 1;
                    const f32x2 ap = l_apow[(d * 33 + tau) * 64 + p], cc = l_c[(d * 16 + hh) * 64 + p];
                    v[jj] = ri ? -(cc.x * ap.y + cc.y * ap.x) : (cc.x * ap.x - cc.y * ap.y);
                }
            }
            u32x4 w; w.x = cvt_pk_bf16(v[0], v[1]); w.y = cvt_pk_bf16(v[2], v[3]); w.z = cvt_pk_bf16(v[4], v[5]); w.w = cvt_pk_bf16(v[6], v[7]);
            *(u32x4*)(gw + W_2 + ((size_t)(ks * 16 + nt) * 64 + ln) * 16) = w;
        }
        __syncthreads();
    }
}

constexpr int AROW = 272, ABUF = 128 * AROW, L_A = 0, L_FG = 2 * ABUF, FGROW = 528, L_XCH = L_FG + 128 * FGROW, YROW = 1040;
static_assert(L_XCH + 4096 <= 147456 && 128 * YROW <= L_XCH, "ssm LDS map");

__device__ __forceinline__ void a_load(u32x4 (&ar)[4], const bf16_t* A, int slice, int tid) {
#pragma unroll
    for (int i = 0; i < 4; ++i) { const int idx = tid + 512 * i, row = idx >> 4, piece = idx & 15; ar[i] = *(const u32x4*)(A + (size_t)row * 512 + slice * 128 + piece * 8); }
}
__device__ __forceinline__ void a_write(const u32x4 (&ar)[4], LAS unsigned char* buf, int tid) {
#pragma unroll
    for (int i = 0; i < 4; ++i) { const int idx = tid + 512 * i, row = idx >> 4, piece = idx & 15; *(LAS u32x4*)(buf + row * AROW + piece * 16) = ar[i]; }
}
__device__ __forceinline__ float gelu_fast(float x) { const float u2 = 1.5957691216057308f * (x + 0.044715f * x * x * x); return x * __builtin_amdgcn_rcpf(1.0f + __expf(-u2)); }

__device__ __forceinline__ void phase(LAS unsigned char* lds, int G) {
    const KA a; unsigned char* ws = a.ws();
    for (int item = blockIdx.x; item < 1024; item += G) {
        int tid = threadIdx.x; asm volatile("" : "+v"(tid));
        const int lane = tid & 63, w = __builtin_amdgcn_readfirstlane(tid >> 6), b = lane & 31, hi = lane >> 5;
        const int g = item & 31, unit = item >> 5, tok0 = unit * 4096; const bool pair = unit < 16;
        const bf16_t* A = (const bf16_t*)(ws + OFF_UGM) + ((size_t)g * M_TOK + tok0) * 16;
        const unsigned char* W1 = ws + OFF_SSMW + (size_t)g * GRP_W + W_1; const unsigned char* W2 = ws + OFF_SSMW + (size_t)g * GRP_W + W_2;
        u32x4 ar[4];
        const int q = w >> 1, mh = w & 1, d = q >> 1, ph = q & 1;
        f32x16 s_re[2], s_im[2];
#pragma unroll
        for (int mt = 0; mt < 2; ++mt)
#pragma unroll
            for (int r = 0; r < 16; ++r) { s_re[mt][r] = 0.f; s_im[mt][r] = 0.f; }
        {
            const int lcb = 32 * ((b >> 2) & 1) + (b & 3) + 4 * (b >> 3);
            const int arow0 = (64 * mh + lcb) * AROW + hi * 16;
            const unsigned char* wre = W1 + ((size_t)(4 * d + ph) * 64 + lane) * 16; const unsigned char* wim = W1 + ((size_t)(4 * d + 2 + ph) * 64 + lane) * 16;
            bf16x8 B0[4][2], B1[4][2];
#define SSM_LOADB1(dst, grp) do { _Pragma("unroll") for (int i_ = 0; i_ < 4; ++i_) { dst[i_][0] = *(const bf16x8*)(wre + (size_t)((grp) * 4 + i_) * 8192); dst[i_][1] = *(const bf16x8*)(wim + (size_t)((grp) * 4 + i_) * 8192); } } while (0)
#define SSM_COMP1(src, buf, kb) do { _Pragma("unroll") for (int i_ = 0; i_ < 4; ++i_) { _Pragma("unroll") for (int mt = 0; mt < 2; ++mt) { \
            const bf16x8 af = *(const LAS bf16x8*)((buf) + arow0 + mt * 16 * AROW + ((kb) + i_) * 32); \
            s_re[mt] = __builtin_amdgcn_mfma_f32_32x32x16_bf16(af, src[i_][0], s_re[mt], 0, 0, 0); s_im[mt] = __builtin_amdgcn_mfma_f32_32x32x16_bf16(af, src[i_][1], s_im[mt], 0, 0, 0); } } } while (0)
            a_load(ar, A, 0, tid);
            SSM_LOADB1(B0, 0);
#pragma unroll 1
            for (int s = 0; s < 4; ++s) {
                LAS unsigned char* buf = lds + L_A + (s & 1) * ABUF;
                a_write(ar, buf, tid);
                if (s < 3) a_load(ar, A, s + 1, tid);
                __syncthreads();
                SSM_LOADB1(B1, 2 * s + 1);
                SSM_COMP1(B0, buf, 0);
                if (s < 3) SSM_LOADB1(B0, 2 * s + 2);
                SSM_COMP1(B1, buf, 4);
            }
#undef SSM_LOADB1
#undef SSM_COMP1
        }
        {
            const f32x2 a32 = *(const f32x2*)(ws + OFF_SSMT + (size_t)g * GRP_T + T_APOW + (size_t)((d * 33 + 32) * 64 + 32 * ph + b) * 8);
            const float ar_ = a32.x, ai_ = a32.y;
            float rr = 0.f, ri_ = 0.f;
            if (d == 0) {
#pragma unroll
                for (int k = 0; k < 32; ++k) { const int mt = k >> 4, r = k & 15; const float er = s_re[mt][r], ei = s_im[mt][r]; s_re[mt][r] = rr; s_im[mt][r] = ri_;
                    const float nr = ar_ * rr - ai_ * ri_ + er, ni = ar_ * ri_ + ai_ * rr + ei; rr = nr; ri_ = ni; }
            } else {
#pragma unroll
                for (int k = 31; k >= 0; --k) { const int mt = k >> 4, r = k & 15; const float er = s_re[mt][r], ei = s_im[mt][r]; s_re[mt][r] = rr; s_im[mt][r] = ri_;
                    const float nr = ar_ * rr - ai_ * ri_ + er, ni = ar_ * ri_ + ai_ * rr + ei; rr = nr; ri_ = ni; }
            }
            LAS f32x2* xch = (LAS f32x2*)(lds + L_XCH);
            const int sg = 2 * mh + hi;
            { f32x2 v; v.x = rr; v.y = ri_; xch[(q * 4 + sg) * 32 + b] = v; }
            __syncthreads();
            float pr = ar_, pi = ai_;
#pragma unroll
            for (int i = 0; i < 5; ++i) { const float nr = pr * pr - pi * pi, ni = 2.f * pr * pi; pr = nr; pi = ni; }
            const f32x2 E0 = xch[(q * 4 + 0) * 32 + b], E1 = xch[(q * 4 + 1) * 32 + b], E2 = xch[(q * 4 + 2) * 32 + b], E3 = xch[(q * 4 + 3) * 32 + b];
            float cr = 0.f, ci = 0.f;
            if (d == 0) {
                float c1r = E0.x, c1i = E0.y;
                float c2r = pair ? 0.f : E1.x + (pr * c1r - pi * c1i), c2i = pair ? 0.f : E1.y + (pr * c1i + pi * c1r);
                float c3r = E2.x + (pr * c2r - pi * c2i), c3i = E2.y + (pr * c2i + pi * c2r);
                cr = sg == 0 ? 0.f : (sg == 1 ? c1r : (sg == 2 ? c2r : c3r)); ci = sg == 0 ? 0.f : (sg == 1 ? c1i : (sg == 2 ? c2i : c3i));
            } else {
                float c2r = E3.x, c2i = E3.y;
                float c1r = pair ? 0.f : E2.x + (pr * c2r - pi * c2i), c1i = pair ? 0.f : E2.y + (pr * c2i + pi * c2r);
                float c0r = E1.x + (pr * c1r - pi * c1i), c0i = E1.y + (pr * c1i + pi * c1r);
                cr = sg == 3 ? 0.f : (sg == 2 ? c2r : (sg == 1 ? c1r : c0r)); ci = sg == 3 ? 0.f : (sg == 2 ? c2i : (sg == 1 ? c1i : c0i));
            }
            LAS bf16_t* fg = (LAS bf16_t*)(lds + L_FG) + (32 * sg) * (FGROW / 2) + 128 * d + 32 * ph + b;
            if (d == 0) {
#pragma unroll
                for (int k = 0; k < 32; ++k) { const int mt = k >> 4, r = k & 15; fg[k * (FGROW / 2)] = f2bf(s_re[mt][r] + cr); fg[k * (FGROW / 2) + 64] = f2bf(s_im[mt][r] + ci);
                    const float nr = ar_ * cr - ai_ * ci, ni = ar_ * ci + ai_ * cr; cr = nr; ci = ni; }
            } else {
#pragma unroll
                for (int k = 31; k >= 0; --k) { const int mt = k >> 4, r = k & 15; fg[k * (FGROW / 2)] = f2bf(s_re[mt][r] + cr); fg[k * (FGROW / 2) + 64] = f2bf(s_im[mt][r] + ci);
                    const float nr = ar_ * cr - ai_ * ci, ni = ar_ * ci + ai_ * cr; cr = nr; ci = ni; }
            }
        }
        f32x16 acc[4][2];
#pragma unroll
        for (int mt = 0; mt < 4; ++mt)
#pragma unroll
            for (int r = 0; r < 16; ++r) { acc[mt][0][r] = 0.f; acc[mt][1][r] = 0.f; }
        {
            const int arow0 = b * AROW + hi * 16;
            const int frow0 = L_FG + b * FGROW + hi * 16;
            const unsigned char* wb = W2 + ((size_t)(2 * w) * 64 + lane) * 16;
            bf16x8 B0[4][2], B1[4][2];
#define SSM_LOADB2(dst, grp) do { _Pragma("unroll") for (int i_ = 0; i_ < 4; ++i_) { dst[i_][0] = *(const bf16x8*)(wb + (size_t)((grp) * 4 + i_) * 16384); dst[i_][1] = *(const bf16x8*)(wb + (size_t)((grp) * 4 + i_) * 16384 + 1024); } } while (0)
#define SSM_COMP2(src, base, rowstride, kb) do { _Pragma("unroll") for (int i_ = 0; i_ < 4; ++i_) { _Pragma("unroll") for (int mt = 0; mt < 4; ++mt) { \
            const bf16x8 af = *(const LAS bf16x8*)(lds + (base) + mt * 32 * (rowstride) + ((kb) + i_) * 32); \
            acc[mt][0] = __builtin_amdgcn_mfma_f32_32x32x16_bf16(af, src[i_][0], acc[mt][0], 0, 0, 0); acc[mt][1] = __builtin_amdgcn_mfma_f32_32x32x16_bf16(af, src[i_][1], acc[mt][1], 0, 0, 0); } } } while (0)
            a_load(ar, A, 0, tid);
            SSM_LOADB2(B0, 0);
#pragma unroll 1
            for (int s = 0; s < 4; ++s) {
                const int bo = L_A + (s & 1) * ABUF;
                a_write(ar, lds + bo, tid);
                if (s < 3) a_load(ar, A, s + 1, tid);
                __syncthreads();
                SSM_LOADB2(B1, 2 * s + 1);
                SSM_COMP2(B0, bo + arow0, AROW, 0);
                SSM_LOADB2(B0, 2 * s + 2);
                SSM_COMP2(B1, bo + arow0, AROW, 4);
            }
            SSM_LOADB2(B1, 9);  SSM_COMP2(B0, frow0, FGROW, 0);
            SSM_LOADB2(B0, 10); SSM_COMP2(B1, frow0, FGROW, 4);
            SSM_LOADB2(B1, 11); SSM_COMP2(B0, frow0, FGROW, 8);
            SSM_COMP2(B1, frow0, FGROW, 12);
#undef SSM_LOADB2
#undef SSM_COMP2
        }
        __syncthreads();
#pragma unroll
        for (int mt = 0; mt < 4; ++mt)
#pragma unroll
            for (int nt = 0; nt < 2; ++nt)
#pragma unroll
                for (int r = 0; r < 16; ++r) {
                    const int c = 32 * mt + (r & 3) + 8 * (r >> 2) + 4 * hi, n2 = 32 * (2 * w + nt) + b;
                    *(LAS bf16_t*)(lds + c * YROW + n2 * 2) = f2bf(gelu_fast(acc[mt][nt][r]));
                }
        __syncthreads();
        bf16_t* Gb = (bf16_t*)(ws + OFF_G);
#pragma unroll 4
        for (int i = 0; i < 16; ++i) {
            const int idx = tid + 512 * i, c = idx >> 6, j = (idx >> 1) & 31, half = idx & 1;
            const u32x4 v = *(const LAS u32x4*)(lds + c * YROW + j * 32 + half * 16);
            *(u32x4*)(Gb + (size_t)(tok0 + 32 * c + j) * 512 + 16 * g + 8 * half) = v;
        }
        __syncthreads();
    }
}
}

__device__ __forceinline__ void final_phase(int wave, int lane, int G) {
    const KA a; const float* rsq2 = (const float*)(a.ws() + OFF_RSQ2); const float* fw = a.in(19); float* outp = a.out();
    f32x4 w[4];
#pragma unroll
    for (int j = 0; j < 4; ++j) w[j] = *(const f32x4*)(fw + j * 256 + lane * 4);
    for (int t = blockIdx.x * 8 + wave; t < M_TOK; t += G * 8) {
        const float rs = rsqrtf(rsq2[t] * (1.0f / DM) + RMS_EPS);
        float* o = outp + (size_t)t * DM;
#pragma unroll
        for (int j = 0; j < 4; ++j) { f32x4 v = *(const f32x4*)(o + j * 256 + lane * 4); v = v * w[j] * rs; *(f32x4*)(o + j * 256 + lane * 4) = v; }
    }
}

constexpr int LDS_BYTES = 147456;
__global__ void __launch_bounds__(512, 2) mega_fwd(Args a_unused) {
    extern __shared__ __attribute__((aligned(16))) unsigned char lds_raw[];
    LAS unsigned char* lds = (LAS unsigned char*)lds_raw;
    cg::grid_group grid = cg::this_grid();
#define WAVE_ID __builtin_amdgcn_readfirstlane(threadIdx.x >> 6)
#define LANE_ID ((int)(threadIdx.x & 63))
#define GRID_N ((int)gridDim.x)

    ssm::stage_a(lds, GRID_N);
    p0_prologue(lds, WAVE_ID, LANE_ID, GRID_N);
    grid.sync();
    ssm::stage_b(lds, GRID_N);
    {
        const KA a; unsigned char* ws = a.ws();
        pg8::Gemm g{(const bf16_t*)(ws + OFF_A), (const bf16_t*)(ws + OFF_WIN), M_TOK, NPROJ, DM}; pg8::StaticOrder S; S.init(M_TOK, NPROJ, GRID_N, (int)blockIdx.x);
        pg8::EpiIn E{(bf16_t*)(ws + OFF_UGM), (bf16_t*)(ws + OFF_SZ), (bf16_t*)(ws + OFF_Q), (bf16_t*)(ws + OFF_KB), (bf16_t*)(ws + OFF_VT), (bf16_t*)(ws + OFF_AZ)};
        pg8::gemm_phase<pg8::EpiIn, pg8::StaticOrder, true, true>(lds, g, S, E);
    }
    grid.sync();
    ssm::phase(lds, GRID_N);
    att::phase(lds, GRID_N);
    grid.sync();
    {
        const KA a; unsigned char* ws = a.ws();
        pg8::Gemm g{(const bf16_t*)(ws + OFF_G), (const bf16_t*)(ws + OFF_WGLU), M_TOK, 512, 512}; pg8::StaticOrder S; S.init(M_TOK, 512, GRID_N, (int)blockIdx.x);
        pg8::EpiGlu E{(const bf16_t*)(ws + OFF_G), (const bf16_t*)(ws + OFF_SZ), a.in(13), (bf16_t*)(ws + OFF_A), (float*)(ws + OFF_RSQ1)};
        pg8::gemm_phase<pg8::EpiGlu, pg8::StaticOrder, true, true>(lds, g, S, E);
    }
    grid.sync();
    {
        const KA a; unsigned char* ws = a.ws();
        pg8::Gemm g{(const bf16_t*)(ws + OFF_A), (const bf16_t*)(ws + OFF_WOUT), M_TOK, DM, DM}; pg8::StaticOrder S; S.init(M_TOK, DM, GRID_N, (int)blockIdx.x);
        pg8::EpiOut E{a.in(0), a.in(1), a.out(), (const float*)(ws + OFF_RSQ1), (float*)(ws + OFF_RSQ2)};
        pg8::gemm_phase<pg8::EpiOut, pg8::StaticOrder, true, true>(lds, g, S, E);
    }
    grid.sync();
    final_phase(WAVE_ID, LANE_ID, GRID_N);
}

extern "C" void kernel_launch(void* const* d_in, const int* in_sizes, int n_in, void* d_out, int out_size, void* d_ws, size_t ws_size, hipStream_t stream) {
    (void)in_sizes; (void)out_size;
    static int grid = 0;
    if (grid == 0) {
        if (n_in != 20 || ws_size < OFF_END) { fprintf(stderr, "kernel_launch: bad arguments (n_in %d, ws %zu < %zu)\n", n_in, ws_size, (size_t)OFF_END); grid = -1; return; }
        int dev = 0, cus = 0, per_cu = 0;
        if (hipGetDevice(&dev) != hipSuccess || hipDeviceGetAttribute(&cus, hipDeviceAttributeMultiprocessorCount, dev) != hipSuccess) { grid = -1; return; }
        if (hipFuncSetAttribute((const void*)mega_fwd, hipFuncAttributeMaxDynamicSharedMemorySize, LDS_BYTES) != hipSuccess) { fprintf(stderr, "kernel_launch: hipFuncSetAttribute failed\n"); grid = -1; return; }
        if (hipOccupancyMaxActiveBlocksPerMultiprocessor(&per_cu, (const void*)mega_fwd, 512, LDS_BYTES) != hipSuccess || per_cu < 1) { fprintf(stderr, "kernel_launch: occupancy query says %d\n", per_cu); grid = -1; return; }
        grid = cus * per_cu;
    }
    if (grid < 0) return;
    Args a{};
    for (int i = 0; i < 20; ++i) a.in[i] = (const float*)d_in[i];
    a.out = (float*)d_out; a.ws = (unsigned char*)d_ws;
    void* args[] = {&a};
    hipError_t e = hipLaunchCooperativeKernel((const void*)mega_fwd, dim3(grid), dim3(512), args, LDS_BYTES, stream);
    if (e != hipSuccess) fprintf(stderr, "cooperative launch failed: %s (grid %d)\n", hipGetErrorString(e), grid);
}
```

```cpp
#include <hip/hip_runtime.h>
#include <hip/hip_cooperative_groups.h>
#include <stdint.h>
#include <stdio.h>
namespace cg = cooperative_groups;

typedef unsigned short bf16_t;
typedef short bf16x8 __attribute__((ext_vector_type(8)));
typedef float f32x16 __attribute__((ext_vector_type(16)));
typedef float f32x4 __attribute__((ext_vector_type(4)));
typedef unsigned u32x4 __attribute__((ext_vector_type(4)));
#define LAS __attribute__((address_space(3)))

constexpr int M_TOK = 131072;
constexpr int M_PROMPT = 65536;
constexpr int DM = 1024;
constexpr int NPROJ = 2304;
constexpr float RMS_EPS = 1e-6f;

__device__ __forceinline__ bf16_t f2bf(float f) { uint32_t u = __float_as_uint(f); u += 0x7fffu + ((u >> 16) & 1u); return (bf16_t)(u >> 16); }
__device__ __forceinline__ float bf2f(bf16_t b) { return __uint_as_float(((uint32_t)b) << 16); }
__device__ __forceinline__ float bflo(unsigned w) { return __uint_as_float(w << 16); }
__device__ __forceinline__ float bfhi(unsigned w) { return __uint_as_float(w & 0xffff0000u); }
__device__ __forceinline__ unsigned cvt_pk_bf16(float lo, float hi) { unsigned r; asm volatile("v_cvt_pk_bf16_f32 %0, %1, %2" : "=v"(r) : "v"(lo), "v"(hi)); return r; }
__device__ __forceinline__ float silu_f(float v) { return v * __builtin_amdgcn_rcpf(1.0f + __expf(-v)); }
__device__ __forceinline__ float sigmoid_f(float v) { return __builtin_amdgcn_rcpf(1.0f + __expf(-v)); }
__device__ __forceinline__ float gelu_tanh_f(float x) { const float u = 0.7978845608028654f * (x + 0.044715f * x * x * x); return 0.5f * x * (1.0f + tanhf(u)); }
__device__ __forceinline__ void tok_seq(int t, int& start, int& len) {
    if (t < M_PROMPT) { len = 2048; start = t & ~2047; } else { len = 4096; start = M_PROMPT + ((t - M_PROMPT) & ~4095); }
}

constexpr size_t MiB = 1024 * 1024;
constexpr size_t OFF_A    = 0;
constexpr size_t OFF_UGM  = 256 * MiB;
constexpr size_t OFF_SZ   = OFF_UGM + 128 * MiB;
constexpr size_t OFF_Q    = OFF_SZ + 128 * MiB;
constexpr size_t OFF_KB   = OFF_Q + 128 * MiB;
constexpr size_t OFF_VT   = OFF_KB + 32 * MiB;
constexpr size_t OFF_AZ   = OFF_VT + 32 * MiB;
constexpr size_t OFF_G    = OFF_AZ + 128 * MiB;
constexpr size_t OFF_WIN  = OFF_G + 128 * MiB;
constexpr size_t OFF_WGLU = OFF_WIN + 5 * MiB;
constexpr size_t OFF_WOUT = OFF_WGLU + 1 * MiB;
constexpr size_t OFF_RSQ1 = OFF_WOUT + 2 * MiB;
constexpr size_t OFF_RSQ2 = OFF_RSQ1 + 512 * 1024;
constexpr size_t OFF_SSMT = OFF_RSQ2 + 512 * 1024;
constexpr size_t OFF_SSMW = OFF_SSMT + 4 * MiB;
constexpr size_t OFF_BAR  = OFF_SSMW + 32 * MiB;
constexpr size_t OFF_END  = OFF_BAR + 64 * 1024;

namespace pg8 {
#define PG8_LAS __attribute__((address_space(3)))
typedef unsigned short bf16_t;
typedef short bf16x8 __attribute__((ext_vector_type(8)));
typedef float f32x4 __attribute__((ext_vector_type(4)));
typedef unsigned u32x4 __attribute__((ext_vector_type(4)));
constexpr int BM = 256, BK = 64, HALF = 128, HTB = HALF * BK * 2  , STAGE_BYTES = 8 * HTB, NXCD = 8, WGM = 8;

__host__ __device__ __forceinline__ int lds_byte(int r, int c) { const int st = (r >> 4) * 2 + (c >> 5), rr = r & 15, cc = c & 31, ob = rr * 64 + cc * 2; return st * 1024 + (ob ^ (((ob >> 9) & 1) << 5)); }
__host__ __device__ __forceinline__ void stage_rc(int b, int& R, int& C) { const int st = b / 1024, sb = b % 1024, swz = sb ^ (((sb >> 9) & 1) << 5); R = (st >> 1) * 16 + swz / 64; C = (st & 1) * 32 + (swz % 64) / 2; }
__host__ __device__ __forceinline__ int perm32(int rho) { const int n = rho >> 4, i = rho & 15; return 8 * (i >> 2) + 4 * n + (i & 3); }

struct Unit { int pm, pn; };
struct Gemm { const bf16_t* A; const bf16_t* Bt; int M, N, K; };

struct StaticOrder {
    int nM, nN, nwg, G, c;
    __host__ __device__ void init(int M, int N, int G_, int c_) { nM = M / BM; nN = N / BM; nwg = nM * nN; G = G_; c = c_; }
    __host__ __device__ bool next(int i, Unit& u) const {
        const long L = (long)i * G + c; if (L >= nwg) return false;
        int wgid = (int)L; { const int q = nwg / NXCD, r = nwg % NXCD, xcd = wgid % NXCD, off = wgid / NXCD; wgid = (xcd < r ? xcd * (q + 1) : r * (q + 1) + (xcd - r) * q) + off; }
        const int nig = WGM * nN, gid = wgid / nig, fm = gid * WGM, gsz = (nM - fm) < WGM ? (nM - fm) : WGM;
        u.pm = fm + ((wgid % nig) % gsz); u.pn = (wgid % nig) / gsz; return true;
    }
    __device__ __forceinline__ void a_ready(const Unit&) const {}
    __device__ __forceinline__ void done(const Unit&) const {}
};


__device__ __forceinline__ u32x4 pack8(const f32x4 a, const f32x4 b) { u32x4 w; w.x = ::cvt_pk_bf16(a[0], a[1]); w.y = ::cvt_pk_bf16(a[2], a[3]); w.z = ::cvt_pk_bf16(b[0], b[1]); w.w = ::cvt_pk_bf16(b[2], b[3]); return w; }
__device__ __forceinline__ f32x4 silu4(const f32x4 v) { f32x4 r; r[0] = ::silu_f(v[0]); r[1] = ::silu_f(v[1]); r[2] = ::silu_f(v[2]); r[3] = ::silu_f(v[3]); return r; }

struct EpiIn {
    static constexpr bool PERM = true, AFTER_DRAIN = false, MIDK = false;
    bf16_t *Ugm, *SZ, *Q, *Kb, *Vt, *AZ;
    __device__ __forceinline__ void operator()(const f32x4 (&acc)[2][2][4][2], const Unit& u, int wr, int wc, int fr, int fq) const {
        asm volatile("" : "+v"(fr), "+v"(fq));
        const int row0 = u.pm * BM + wr * 64 + fr, cl = wc * 32 + 8 * fq, pn = u.pn;
#pragma unroll
        for (int ai = 0; ai < 2; ++ai)
#pragma unroll
            for (int m = 0; m < 4; ++m) {
                const size_t row = (size_t)(row0 + ai * HALF + m * 16);
#pragma unroll
                for (int bj = 0; bj < 2; ++bj) {
                    const f32x4 v0 = acc[ai][bj][m][0], v1 = acc[ai][bj][m][1];
                    const int c = pn * BM + bj * HALF + cl;
                    if (pn < 2) { *(u32x4*)(Ugm + ((size_t)(c >> 4) * M_TOK + row) * 16 + (c & 15)) = pack8(v0, v1); }
                    else if (pn < 4) { *(u32x4*)(SZ + row * 512 + (c - 512)) = pack8(silu4(v0), silu4(v1)); }
                    else if (pn < 6) { *(u32x4*)(Q + row * 512 + (c - 1024)) = pack8(v0 * 0.125f, v1 * 0.125f); }
                    else if (pn == 6) {
                        if (bj == 0) { *(u32x4*)(Kb + row * 128 + cl) = pack8(v0, v1); }
                        else {
                            bf16_t* vp = Vt + (size_t)cl * M_TOK + row;
#pragma unroll
                            for (int j = 0; j < 4; ++j) { vp[(size_t)j * M_TOK] = ::f2bf(v0[j]); vp[(size_t)(j + 4) * M_TOK] = ::f2bf(v1[j]); }
                        }
                    }
                    else { *(u32x4*)(AZ + row * 512 + (c - 1792)) = pack8(silu4(v0), silu4(v1)); }
                }
            }
    }
};

struct EpiGlu {
    static constexpr bool PERM = true, AFTER_DRAIN = false, MIDK = false;
    const bf16_t *G, *SZ; const float* b_glu; bf16_t* MIX; float* rsq1;
    __device__ __forceinline__ void operator()(const f32x4 (&acc)[2][2][4][2], const Unit& u, int wr, int wc, int fr, int fq) const {
        asm volatile("" : "+v"(fr), "+v"(fq));
        const int row0 = u.pm * BM + wr * 64 + fr, cl = wc * 32 + 8 * fq, pn = u.pn;
        f32x4 bv[2][2];
#pragma unroll
        for (int bj = 0; bj < 2; ++bj) { bv[bj][0] = *(const f32x4*)(b_glu + pn * BM + bj * HALF + cl); bv[bj][1] = *(const f32x4*)(b_glu + pn * BM + bj * HALF + cl + 4); }
#pragma unroll
        for (int ai = 0; ai < 2; ++ai)
#pragma unroll
            for (int m = 0; m < 4; ++m) {
                const size_t row = (size_t)(row0 + ai * HALF + m * 16);
                float sq = 0.f;
#pragma unroll
                for (int bj = 0; bj < 2; ++bj) {
                    const int c = pn * BM + bj * HALF + cl;
                    const u32x4 gw = *(const u32x4*)(G + row * 512 + c), zw = *(const u32x4*)(SZ + row * 512 + c);
                    const f32x4 a0 = acc[ai][bj][m][0] + bv[bj][0], a1 = acc[ai][bj][m][1] + bv[bj][1];
                    f32x4 g0, g1, z0, z1;
                    g0[0] = ::bflo(gw.x); g0[1] = ::bfhi(gw.x); g0[2] = ::bflo(gw.y); g0[3] = ::bfhi(gw.y); g1[0] = ::bflo(gw.z); g1[1] = ::bfhi(gw.z); g1[2] = ::bflo(gw.w); g1[3] = ::bfhi(gw.w);
                    z0[0] = ::bflo(zw.x); z0[1] = ::bfhi(zw.x); z0[2] = ::bflo(zw.y); z0[3] = ::bfhi(zw.y); z1[0] = ::bflo(zw.z); z1[1] = ::bfhi(zw.z); z1[2] = ::bflo(zw.w); z1[3] = ::bfhi(zw.w);
                    f32x4 v0, v1;
#pragma unroll
                    for (int j = 0; j < 4; ++j) { v0[j] = g0[j] * ::sigmoid_f(a0[j]); v1[j] = g1[j] * ::sigmoid_f(a1[j]); sq += v0[j] * v0[j] + v1[j] * v1[j]; }
                    *(u32x4*)(MIX + row * 1024 + c) = pack8(v0 * z0, v1 * z1);
                }
                sq += __shfl_xor(sq, 16); sq += __shfl_xor(sq, 32);
                if (fq == 0) atomicAdd(rsq1 + row, sq);
                if (m & 1) asm volatile("" ::: "memory");
            }
    }
};

struct EpiOut {
    static constexpr bool PERM = false, AFTER_DRAIN = false, MIDK = true;
    const float *xp, *xs; float* out; const float* rsq1; float* rsq2;
    __device__ __forceinline__ void mid(f32x4 (&acc)[2][2][4][2], const Unit& u, int wr, int wc, int fr, int fq) const {
        asm volatile("" : "+v"(fr));
#pragma unroll
        for (int ai = 0; ai < 2; ++ai)
#pragma unroll
            for (int m = 0; m < 4; ++m) {
                const int row = u.pm * BM + ai * HALF + wr * 64 + m * 16 + fr;
                const float rs = rsqrtf(rsq1[row] * (1.0f / 512.0f) + ::RMS_EPS);
#pragma unroll
                for (int bj = 0; bj < 2; ++bj)
#pragma unroll
                    for (int n = 0; n < 2; ++n) acc[ai][bj][m][n] = acc[ai][bj][m][n] * rs;
            }
    }
    __device__ __forceinline__ void operator()(const f32x4 (&acc)[2][2][4][2], const Unit& u, int wr, int wc, int fr, int fq) const {
        asm volatile("" : "+v"(fr), "+v"(fq));
        const int col0 = u.pn * BM + wc * 32 + 4 * fq, r0 = u.pm * BM;
        const float* xb = (r0 < ::M_PROMPT) ? xp + (size_t)r0 * 1024 : xs + (size_t)(r0 - ::M_PROMPT) * 1024;
        float* ob = out + (size_t)r0 * 1024;
#pragma unroll
        for (int ai = 0; ai < 2; ++ai)
#pragma unroll
            for (int m = 0; m < 4; ++m) {
                const int rl = ai * HALF + wr * 64 + m * 16 + fr;
                float sq = 0.f;
#pragma unroll
                for (int bj = 0; bj < 2; ++bj)
#pragma unroll
                    for (int n = 0; n < 2; ++n) {
                        const size_t off = (size_t)rl * 1024 + col0 + bj * HALF + n * 16;
                        const f32x4 r = *(const f32x4*)(xb + off) + acc[ai][bj][m][n];
                        *(f32x4*)(ob + off) = r;
                        sq += (r[0] * r[0] + r[1] * r[1]) + (r[2] * r[2] + r[3] * r[3]);
                    }
                sq += __shfl_xor(sq, 16); sq += __shfl_xor(sq, 32);
                if (fq == 0) atomicAdd(rsq2 + r0 + rl, sq);
                if (m & 1) asm volatile("" ::: "memory");
            }
    }
};

template <class Epi, class Sched, bool ALIGN_EPI = false, bool SP2 = false>
__device__ __forceinline__ void gemm_phase(PG8_LAS unsigned char* lds, const Gemm g, const Sched& S, const Epi& E) {
    int tid_ = threadIdx.x; asm volatile("" : "+v"(tid_));
    const int tid = tid_, wid = __builtin_amdgcn_readfirstlane(tid >> 6), lane = tid & 63, wr = wid >> 2, wc = wid & 3, fr = lane & 15, fq = lane >> 4;
    const int K = g.K, nt = K / BK;
    unsigned voffA[2], voffB[2];
#pragma unroll
    for (int i = 0; i < 2; ++i) { int R, C; stage_rc(tid * 16 + i * 8192, R, C); const int Rb = Epi::PERM ? ((R & ~31) + perm32(R & 31)) : R;
        voffA[i] = (unsigned)(R * K + C) * 2u; voffB[i] = (unsigned)(Rb * K + C) * 2u; }
    const size_t kstep = (size_t)(BK * 2);
    const size_t hstep = (size_t)HALF * K * 2;
    const size_t tstep = 2 * hstep;
    const unsigned ldsw = (unsigned)wid * 1024u;
    const int aoff = lds_byte(wr * 64 + fr, fq * 8), boff = lds_byte(wc * 32 + fr, fq * 8);
#define PG8_SA(b, h) (((b) * 2 + (h)) * HTB)
#define PG8_SB(b, h) ((4 + (b) * 2 + (h)) * HTB)
#define PG8_STAGE(bufoff, gbase, voff) do { _Pragma("unroll") for (int _i = 0; _i < 2; ++_i) \
        __builtin_amdgcn_global_load_lds((const unsigned*)((const char*)(gbase) + (voff)[_i]), (PG8_LAS unsigned*)(lds + (bufoff) + ldsw + _i * 8192), 16, 0, 0); } while (0)
#define PG8_LDA(dst, b, h) do { _Pragma("unroll") for (int m = 0; m < 4; ++m) _Pragma("unroll") for (int k = 0; k < 2; ++k) dst[m][k] = *(const PG8_LAS bf16x8*)(lds + PG8_SA(b, h) + aoff + m * 2048 + k * 1024); } while (0)
#define PG8_LDB(dst, b, h) do { _Pragma("unroll") for (int n = 0; n < 2; ++n) _Pragma("unroll") for (int k = 0; k < 2; ++k) dst[n][k] = *(const PG8_LAS bf16x8*)(lds + PG8_SB(b, h) + boff + n * 2048 + k * 1024); } while (0)
#define PG8_MMA(ai, bj, At, Bt) do { __builtin_amdgcn_s_setprio(1); _Pragma("unroll") for (int m = 0; m < 4; ++m) _Pragma("unroll") for (int n = 0; n < 2; ++n) _Pragma("unroll") for (int k = 0; k < 2; ++k) \
        acc[ai][bj][m][n] = __builtin_amdgcn_mfma_f32_16x16x32_bf16(Bt[n][k], At[m][k], acc[ai][bj][m][n], 0, 0, 0); __builtin_amdgcn_s_setprio(0); } while (0)
#define PG8_WAIT_V(n) asm volatile("s_waitcnt vmcnt(" #n ")" ::: "memory")
#define PG8_WAIT_L(n) asm volatile("s_waitcnt lgkmcnt(" #n ")" ::: "memory")
#define PG8_BAR __builtin_amdgcn_s_barrier()
#define PG8_SCHED __builtin_amdgcn_sched_barrier(0)
    Unit cur, nxt; int ui = 0;
    if (!S.next(0, cur)) return;
    f32x4 acc[2][2][4][2];
#pragma unroll
    for (int a = 0; a < 2; ++a)
#pragma unroll
        for (int b = 0; b < 2; ++b)
#pragma unroll
            for (int m = 0; m < 4; ++m)
#pragma unroll
                for (int n = 0; n < 2; ++n) acc[a][b][m][n] = (f32x4){0.f, 0.f, 0.f, 0.f};
    bf16x8 At[4][2], B0[2][2], B1[2][2];
    const char* cA = (const char*)g.A + (size_t)cur.pm * tstep; const char* cB = (const char*)g.Bt + (size_t)cur.pn * tstep;
    S.a_ready(cur);
    if constexpr (SP2) {
        PG8_STAGE(PG8_SB(0, 0), cB, voffB); PG8_STAGE(PG8_SB(0, 1), cB + hstep, voffB); PG8_STAGE(PG8_SA(0, 0), cA, voffA); PG8_STAGE(PG8_SA(0, 1), cA + hstep, voffA);
        if (wr == 1) PG8_BAR;
        PG8_WAIT_V(2); PG8_BAR;
        PG8_STAGE(PG8_SB(1, 0), cB + kstep, voffB); PG8_STAGE(PG8_SA(1, 0), cA + kstep, voffA); PG8_STAGE(PG8_SB(1, 1), cB + hstep + kstep, voffB);
        PG8_WAIT_V(6); PG8_BAR;
    } else {
        PG8_STAGE(PG8_SB(0, 0), cB, voffB); PG8_STAGE(PG8_SA(0, 0), cA, voffA); PG8_STAGE(PG8_SB(0, 1), cB + hstep, voffB); PG8_STAGE(PG8_SA(0, 1), cA + hstep, voffA);
        if (wr == 1) PG8_BAR;
        PG8_WAIT_V(4); PG8_BAR;
        PG8_STAGE(PG8_SB(1, 0), cB + kstep, voffB); PG8_STAGE(PG8_SA(1, 0), cA + kstep, voffA); PG8_STAGE(PG8_SB(1, 1), cB + hstep + kstep, voffB);
        PG8_WAIT_V(6); PG8_BAR;
    }
    for (;;) {
        const bool has_next = S.next(ui + 1, nxt);
        const char* nA = has_next ? (const char*)g.A + (size_t)nxt.pm * tstep : cA; const char* nB = has_next ? (const char*)g.Bt + (size_t)nxt.pn * tstep : cB;
        for (int t = 0; t < nt; t += 2) {
            if constexpr (Epi::MIDK) { if (t == (nt >> 1)) E.mid(acc, cur, wr, wc, fr, fq); }
            const bool last = (t == nt - 2);
            const char* a1 = cA + (size_t)(t + 1) * kstep;
            const char* a2 = last ? nA : cA + (size_t)(t + 2) * kstep; const char* b2 = last ? nB : cB + (size_t)(t + 2) * kstep;
            const char* a3 = a2 + kstep; const char* b3 = b2 + kstep;
            if (last && has_next) S.a_ready(nxt);
            if constexpr (SP2) {
            PG8_LDB(B0, 0, 0); PG8_LDB(B1, 0, 1); PG8_SCHED; PG8_LDA(At, 0, 0); PG8_STAGE(PG8_SA(1, 1), a1 + hstep, voffA);
            PG8_WAIT_V(8); PG8_WAIT_L(0); PG8_BAR; PG8_MMA(0, 0, At, B0); PG8_MMA(0, 1, At, B1); PG8_BAR; PG8_SCHED;
            PG8_LDA(At, 0, 1); PG8_STAGE(PG8_SB(0, 0), b2, voffB); PG8_STAGE(PG8_SB(0, 1), b2 + hstep, voffB); PG8_STAGE(PG8_SA(0, 0), a2, voffA);
            PG8_WAIT_V(8); PG8_WAIT_L(0); PG8_BAR; PG8_MMA(1, 0, At, B0); PG8_MMA(1, 1, At, B1); PG8_BAR; PG8_SCHED;
            PG8_LDB(B0, 1, 0); PG8_LDB(B1, 1, 1); PG8_SCHED; PG8_LDA(At, 1, 0); PG8_STAGE(PG8_SA(0, 1), a2 + hstep, voffA);
            PG8_WAIT_V(8); PG8_WAIT_L(0); PG8_BAR; PG8_MMA(0, 0, At, B0); PG8_MMA(0, 1, At, B1); PG8_BAR; PG8_SCHED;
            PG8_LDA(At, 1, 1); PG8_STAGE(PG8_SB(1, 0), b3, voffB); PG8_STAGE(PG8_SB(1, 1), b3 + hstep, voffB); PG8_STAGE(PG8_SA(1, 0), a3, voffA);
            PG8_WAIT_V(8); PG8_WAIT_L(0); PG8_BAR; PG8_MMA(1, 0, At, B0); PG8_MMA(1, 1, At, B1); PG8_BAR; PG8_SCHED;
            } else {
            PG8_LDB(B0, 0, 0); PG8_SCHED; PG8_LDA(At, 0, 0); PG8_STAGE(PG8_SA(1, 1), a1 + hstep, voffA);
            PG8_WAIT_L(8); PG8_BAR; PG8_WAIT_L(0); PG8_MMA(0, 0, At, B0); PG8_BAR; PG8_SCHED;
            PG8_LDB(B1, 0, 1); PG8_STAGE(PG8_SB(0, 0), b2, voffB);
            PG8_BAR; PG8_WAIT_L(0); PG8_MMA(0, 1, At, B1); PG8_BAR;
            PG8_LDA(At, 0, 1); PG8_STAGE(PG8_SA(0, 0), a2, voffA);
            PG8_BAR; PG8_WAIT_L(0); PG8_MMA(1, 0, At, B0); PG8_BAR; PG8_SCHED;
            PG8_STAGE(PG8_SB(0, 1), b2 + hstep, voffB);
            PG8_WAIT_V(6); PG8_BAR; PG8_MMA(1, 1, At, B1); PG8_BAR;
            PG8_LDB(B0, 1, 0); PG8_SCHED; PG8_LDA(At, 1, 0); PG8_STAGE(PG8_SA(0, 1), a2 + hstep, voffA);
            PG8_WAIT_L(8); PG8_BAR; PG8_WAIT_L(0); PG8_MMA(0, 0, At, B0); PG8_BAR; PG8_SCHED;
            PG8_LDB(B1, 1, 1); PG8_STAGE(PG8_SB(1, 0), b3, voffB);
            PG8_BAR; PG8_WAIT_L(0); PG8_MMA(0, 1, At, B1); PG8_BAR;
            PG8_LDA(At, 1, 1); PG8_STAGE(PG8_SA(1, 0), a3, voffA);
            PG8_BAR; PG8_WAIT_L(0); PG8_MMA(1, 0, At, B0); PG8_BAR; PG8_SCHED;
            PG8_STAGE(PG8_SB(1, 1), b3 + hstep, voffB);
            PG8_WAIT_V(6); PG8_BAR; PG8_MMA(1, 1, At, B1); PG8_BAR;
            }
        }
        if constexpr (ALIGN_EPI) { if (wr == 0) PG8_BAR; }
        if constexpr (!Epi::AFTER_DRAIN) { E(acc, cur, wr, wc, fr, fq); S.done(cur); }
        if (!has_next) break;
#pragma unroll
        for (int a = 0; a < 2; ++a)
#pragma unroll
            for (int b = 0; b < 2; ++b)
#pragma unroll
                for (int m = 0; m < 4; ++m)
#pragma unroll
                    for (int n = 0; n < 2; ++n) acc[a][b][m][n] = (f32x4){0.f, 0.f, 0.f, 0.f};
        cur = nxt; cA = nA; cB = nB; ++ui;
        if constexpr (ALIGN_EPI) { if (wr == 1) PG8_BAR; }
    }
    PG8_WAIT_V(0);
    if constexpr (!ALIGN_EPI) { if (wr == 0) PG8_BAR; }
    PG8_BAR;
    if constexpr (Epi::AFTER_DRAIN) { E.fused(acc, cur, wr, wc, fr, fq, lds, wid, lane); S.done(cur); }
#undef PG8_SA
#undef PG8_SB
#undef PG8_STAGE
#undef PG8_LDA
#undef PG8_LDB
#undef PG8_MMA
#undef PG8_WAIT_V
#undef PG8_WAIT_L
#undef PG8_BAR
#undef PG8_SCHED
}
}

#define XB_TMO      128
#define XB_XCNT(j)  (256  + 64 * (j))
#define XB_XSUB(j)  (1280 + 64 * (j))
#define XB_XGEN(j)  (2304 + 64 * (j))
#define XB_TOP      3328
#define XB_TOPGEN   3392
#define XCD_BAR_WORDS 3456
#define XB_SPIN_CAP (1u << 18)

__device__ __forceinline__ unsigned xb_ld(unsigned* p)              { return __hip_atomic_load(p, __ATOMIC_RELAXED, __HIP_MEMORY_SCOPE_AGENT); }
__device__ __forceinline__ unsigned xb_add(unsigned* p, unsigned v) { return __hip_atomic_fetch_add(p, v, __ATOMIC_RELAXED, __HIP_MEMORY_SCOPE_AGENT); }
__device__ __forceinline__ unsigned xb_xcc_id() { return (unsigned)__builtin_amdgcn_s_getreg((3 << 11) | 20) & 0xFu; }
#define XB_SPIN(cond, bar) do { unsigned _sp = 0; while (cond) { __builtin_amdgcn_s_sleep(1); \
    if ((++_sp & 255u) == 0u) { if (xb_ld(&(bar)[XB_TMO])) break; if (_sp > XB_SPIN_CAP) { atomicAdd(&(bar)[XB_TMO], 1u); break; } } } } while (0)

struct XcdBarrier {
    unsigned* bar; unsigned x;
    volatile LAS unsigned* st;
};

__device__ __forceinline__ XcdBarrier xcd_barrier_post(unsigned* bar, volatile LAS unsigned* st) {
    XcdBarrier b; b.bar = bar; b.x = xb_xcc_id(); b.st = st;
    if (threadIdx.x == 0) (void)xb_add(&bar[XB_XCNT(b.x)], 1u);
    return b;
}
__device__ __forceinline__ void xcd_barrier_complete(unsigned* bar, unsigned x, unsigned& nloc, unsigned& nx) {
    const unsigned G = gridDim.x * gridDim.y * gridDim.z;
    unsigned sum, cnt, mine, sp = 0u;
    for (;;) {
        sum = 0u; cnt = 0u; mine = 0u;
#pragma unroll
        for (unsigned j = 0; j < 16; ++j) { const unsigned c = xb_ld(&bar[XB_XCNT(j)]); sum += c; cnt += (c > 0u) ? 1u : 0u; mine = (j == x) ? c : mine; }
        if (sum == G) break;
        __builtin_amdgcn_s_sleep(1);
        if ((++sp & 255u) == 0u) { if (xb_ld(&bar[XB_TMO])) break; if (sp > XB_SPIN_CAP) { atomicAdd(&bar[XB_TMO], 1u); break; } }
    }
    nloc = mine > 0u ? mine : 1u; nx = cnt > 0u ? cnt : 1u;
}

__device__ __forceinline__ void xcd_barrier(const XcdBarrier& b) {
    asm volatile("s_waitcnt vmcnt(0)" ::: "memory");
    __syncthreads();
    if (threadIdx.x == 0) {
        unsigned* bar = b.bar;
        __builtin_amdgcn_s_waitcnt(0);
        unsigned nloc = b.st[0], nx = b.st[1];
        if (nloc == 0u) { xcd_barrier_complete(bar, b.x, nloc, nx); b.st[0] = nloc; b.st[1] = nx; }
        const unsigned old = xb_add(&bar[XB_XSUB(b.x)], 1u);
        const unsigned gen = old / nloc;
        if (old + 1u == (gen + 1u) * nloc) {
            __builtin_amdgcn_fence(__ATOMIC_RELEASE, "agent");
            asm volatile("s_waitcnt vmcnt(0)" ::: "memory");
            const unsigned og = xb_add(&bar[XB_TOP], 1u);
            const unsigned tg = og / nx;
            if (og + 1u == (tg + 1u) * nx) xb_add(&bar[XB_TOPGEN], 1u);
            else XB_SPIN(xb_ld(&bar[XB_TOPGEN]) == tg, bar);
            __builtin_amdgcn_fence(__ATOMIC_ACQUIRE, "agent");
            xb_add(&bar[XB_XGEN(b.x)], 1u);
            asm volatile("s_waitcnt vmcnt(0)" ::: "memory");
        } else {
            XB_SPIN(xb_ld(&bar[XB_XGEN(b.x)]) == gen, bar);
            __builtin_amdgcn_fence(__ATOMIC_ACQUIRE, "agent");
            asm volatile("s_waitcnt vmcnt(0)" ::: "memory");
        }
    }
    __syncthreads();
}

struct Args {
    const float* in[20];
    float* out; unsigned char* ws;
};
typedef const unsigned char __attribute__((address_space(4)))* kptr_t;
struct KA {
    kptr_t p;
    __device__ __forceinline__ KA() { p = (kptr_t)__builtin_amdgcn_kernarg_segment_ptr(); asm volatile("" : "+s"(p)); }
    __device__ __forceinline__ const float* in(int i) const { return *(const float* const __attribute__((address_space(4)))*)(p + 8 * i); }
    __device__ __forceinline__ float* out() const { return *(float* const __attribute__((address_space(4)))*)(p + 160); }
    __device__ __forceinline__ unsigned char* ws() const { return *(unsigned char* const __attribute__((address_space(4)))*)(p + 168); }
};

__device__ __forceinline__ float wave_sum(float v) {
#pragma unroll
    for (int o = 1; o < 64; o <<= 1) v += __shfl_xor(v, o);
    return v;
}

__device__ __forceinline__ void p0_transpose_item(const float* __restrict__ w, int K, int N, const float* __restrict__ s1, const float* __restrict__ s2, int ksplit, bf16_t* __restrict__ out,
                                                  LAS float* scr, int item, int lane) {
    const int nblk = N / 32, kb = item / nblk, nb = item % nblk, k0 = 32 * kb, n0 = 32 * nb;
#pragma unroll 4
    for (int i = 0; i < 16; ++i) {
        const int kk = 2 * i + (lane >> 5), k = k0 + kk; float sc = 1.0f;
        if (s1) sc = (k < ksplit) ? s1[k] : s2[k - ksplit];
        scr[kk * 33 + (lane & 31)] = w[(size_t)k * N + n0 + (lane & 31)] * sc;
    }
    asm volatile("s_waitcnt lgkmcnt(0)" ::: "memory");
#pragma unroll 4
    for (int j = 0; j < 16; ++j) { const int n = 2 * j + (lane >> 5), k = lane & 31; out[(size_t)(n0 + n) * K + k0 + k] = f2bf(scr[k * 33 + n]); }
    asm volatile("s_waitcnt lgkmcnt(0)" ::: "memory");
}

__device__ __forceinline__ void p0_prologue(LAS unsigned char* lds, int wave, int lane, int G) {
    const KA a; unsigned char* ws = a.ws();
    LAS float* scr = (LAS float*)(lds + wave * 4352);
    const int gw = blockIdx.x * 8 + wave, NGW = G * 8;
    constexpr int I_IN = (DM / 32) * (NPROJ / 32), I_GLU = 16 * 16, I_OUT = 32 * 32;
    for (int it = gw; it < I_IN + I_GLU + I_OUT; it += NGW) {
        int r = it;
        if (r < I_IN) { p0_transpose_item(a.in(3), DM, NPROJ, a.in(2), a.in(2), DM, (bf16_t*)(ws + OFF_WIN), scr, r, lane); continue; } r -= I_IN;
        if (r < I_GLU) { p0_transpose_item(a.in(12), 512, 512, nullptr, nullptr, 0, (bf16_t*)(ws + OFF_WGLU), scr, r, lane); continue; } r -= I_GLU;
        p0_transpose_item(a.in(17), DM, DM, a.in(14), a.in(16), 512, (bf16_t*)(ws + OFF_WOUT), scr, r, lane);
    }
    bf16_t* H = (bf16_t*)(ws + OFF_A);
    const float* xp = a.in(0); const float* xs = a.in(1);
    for (int t = 2 * gw; t < M_TOK; t += 2 * NGW) {
        const float* x = (t < M_PROMPT) ? xp + (size_t)t * DM : xs + (size_t)(t - M_PROMPT) * DM;
        f32x4 v[2][4]; float s[2] = {0.f, 0.f};
#pragma unroll
        for (int rr = 0; rr < 2; ++rr)
#pragma unroll
            for (int j = 0; j < 4; ++j) v[rr][j] = *(const f32x4*)(x + rr * DM + j * 256 + lane * 4);
#pragma unroll
        for (int rr = 0; rr < 2; ++rr)
#pragma unroll
            for (int j = 0; j < 4; ++j) s[rr] += (v[rr][j][0] * v[rr][j][0] + v[rr][j][1] * v[rr][j][1]) + (v[rr][j][2] * v[rr][j][2] + v[rr][j][3] * v[rr][j][3]);
#pragma unroll
        for (int rr = 0; rr < 2; ++rr) {
            const float rs = rsqrtf(wave_sum(s[rr]) * (1.0f / DM) + RMS_EPS);
#pragma unroll
            for (int j = 0; j < 4; ++j) { uint2 w; w.x = cvt_pk_bf16(v[rr][j][0] * rs, v[rr][j][1] * rs); w.y = cvt_pk_bf16(v[rr][j][2] * rs, v[rr][j][3] * rs); *(uint2*)(H + (size_t)(t + rr) * DM + j * 256 + lane * 4) = w; }
        }
    }
    float* rsq = (float*)(ws + OFF_RSQ1);
    for (int i = blockIdx.x * 512 + threadIdx.x; i < 2 * M_TOK; i += G * 512) rsq[i] = 0.f;
}

__device__ __forceinline__ int t5_bucket(int rel) {
    const int n = rel < 0 ? -rel : rel; int b = rel > 0 ? 16 : 0;
    if (n < 8) return b + n;
    const float nf = (float)n;
    int large = 8 + (int)(logf(nf / 8.0f) / 2.772588722239781f * 8.0f);
    if (large > 15) large = 15;
    return b + large;
}
namespace att {
constexpr int L_BIAS = 0, L_K = 10240, L_VT = 28672, L_SSQ = 47104, L_OST = 49152;
constexpr int KROW = 144, VROW = 72, OROW = 144, KBUF = 9216, VBUF = 9216;
typedef unsigned long long u64;

__device__ __forceinline__ void tile(const LAS unsigned char* kb, const LAS unsigned char* vb, const LAS float* btw, const bf16x8 (&q)[4], f32x16& o0, f32x16& o1, float& m, float& l, int delta, int b, int hi) {
    f32x16 p;
#pragma unroll
    for (int r = 0; r < 16; ++r) p[r] = 0.f;
#pragma unroll
    for (int s = 0; s < 4; ++s) { const bf16x8 kf = *(const LAS bf16x8*)(kb + b * KROW + s * 32 + hi * 16); p = __builtin_amdgcn_mfma_f32_32x32x16_bf16(kf, q[s], p, 0, 0, 0); }
    const LAS float* bp = btw + (32 * delta + 32 + 4 * hi - b);
#pragma unroll
    for (int r = 0; r < 16; ++r) p[r] += bp[(r & 3) + 8 * (r >> 2)];
    if (delta == 0) {
#pragma unroll
        for (int r = 0; r < 16; ++r) { const int aa = (r & 3) + 8 * (r >> 2) + 4 * hi; if (aa < b) p[r] = -1e30f; }
    } else if (delta == 8) {
#pragma unroll
        for (int r = 0; r < 16; ++r) { const int aa = (r & 3) + 8 * (r >> 2) + 4 * hi; if (aa > b) p[r] = -1e30f; }
    }
    float tm = p[0];
#pragma unroll
    for (int r = 1; r < 16; ++r) tm = fmaxf(tm, p[r]);
    tm = fmaxf(tm, __shfl_xor(tm, 32));
    const float mn = fmaxf(m, tm), alpha = __expf(m - mn);
    m = mn;
    float rs = 0.f;
#pragma unroll
    for (int r = 0; r < 16; ++r) { p[r] = __expf(p[r] - mn); rs += p[r]; }
    l = l * alpha + rs;
    o0 = o0 * alpha; o1 = o1 * alpha;
    bf16x8 pf[2];
#pragma unroll
    for (int s = 0; s < 2; ++s) {
        u32x4 w; w.x = cvt_pk_bf16(p[8 * s + 0], p[8 * s + 1]); w.y = cvt_pk_bf16(p[8 * s + 2], p[8 * s + 3]); w.z = cvt_pk_bf16(p[8 * s + 4], p[8 * s + 5]); w.w = cvt_pk_bf16(p[8 * s + 6], p[8 * s + 7]);
        pf[s] = __builtin_bit_cast(bf16x8, w);
    }
#pragma unroll
    for (int s = 0; s < 2; ++s) {
        { const LAS unsigned char* vp = vb + b * VROW + 32 * s + 8 * hi; const u64 lo = *(const LAS u64*)vp, hh = *(const LAS u64*)(vp + 16);
          typedef u64 u64x2 __attribute__((ext_vector_type(2))); u64x2 t; t.x = lo; t.y = hh; o0 = __builtin_amdgcn_mfma_f32_32x32x16_bf16(__builtin_bit_cast(bf16x8, t), pf[s], o0, 0, 0, 0); }
        { const LAS unsigned char* vp = vb + (32 + b) * VROW + 32 * s + 8 * hi; const u64 lo = *(const LAS u64*)vp, hh = *(const LAS u64*)(vp + 16);
          typedef u64 u64x2 __attribute__((ext_vector_type(2))); u64x2 t; t.x = lo; t.y = hh; o1 = __builtin_amdgcn_mfma_f32_32x32x16_bf16(__builtin_bit_cast(bf16x8, t), pf[s], o1, 0, 0, 0); }
    }
}

__device__ __forceinline__ void phase(LAS unsigned char* lds, int G) {
    const KA a; unsigned char* ws = a.ws();
    const bf16_t* Q = (const bf16_t*)(ws + OFF_Q); const bf16_t* Kb = (const bf16_t*)(ws + OFF_KB); const bf16_t* Vt = (const bf16_t*)(ws + OFF_VT); const bf16_t* AZ = (const bf16_t*)(ws + OFF_AZ);
    bf16_t* MIX = (bf16_t*)(ws + OFF_A);
    int tid_ = threadIdx.x; asm volatile("" : "+v"(tid_));
    const int tid = tid_, lane = tid & 63, hq = __builtin_amdgcn_readfirstlane(tid >> 6), kvh = hq >> 2, b = lane & 31, hi = lane >> 5;
    {
        const float* rel_bias = a.in(18);
        LAS float* bt = (LAS float*)(lds + L_BIAS);
        for (int e = tid; e < 8 * 320; e += 512) { const int h = e / 320, rel = (e % 320) - 160; bt[e] = (rel >= -128 && rel <= 128) ? rel_bias[t5_bucket(rel) * 8 + h] : 0.f; }
    }
    const float sinkv = a.in(15)[hq];
    const LAS float* btw = (const LAS float*)(lds + L_BIAS) + hq * 320;
    LAS float* ssq = (LAS float*)(lds + L_SSQ);
    LAS unsigned char* ost = lds + L_OST + hq * (64 * OROW);
    const int kkey = tid >> 4, kchunk = tid & 15, vch = tid >> 2, vpart = tid & 3;
    const int kl = (kchunk >> 3) * (32 * KROW) + kkey * KROW + (kchunk & 7) * 16;
    const int vl = (vch >> 6) * (64 * VROW) + (vch & 63) * VROW + vpart * 16;
    for (int item = blockIdx.x; item < M_TOK / 64; item += G) {
        const int q0 = item * 64; int start, len; tok_seq(q0, start, len); const int end = start + len;
        bf16x8 qf[2][4];
#pragma unroll
        for (int i = 0; i < 2; ++i)
#pragma unroll
            for (int s = 0; s < 4; ++s) qf[i][s] = *(const bf16x8*)(Q + (size_t)(q0 + 32 * i + b) * 512 + hq * 64 + 16 * s + 8 * hi);
        f32x16 o[2][2]; float m[2], l[2];
#pragma unroll
        for (int i = 0; i < 2; ++i) { m[i] = sinkv; l[i] = hi ? 0.f : 1.f;
#pragma unroll
            for (int r = 0; r < 16; ++r) { o[i][0][r] = 0.f; o[i][1][r] = 0.f; } }
        u32x4 kreg, vreg;
        { const int ks = q0 - 128; if (ks >= start && ks < end) { kreg = *(const u32x4*)(Kb + (size_t)(ks + kkey) * 128 + kchunk * 8); vreg = *(const u32x4*)(Vt + (size_t)vch * M_TOK + ks + vpart * 8); } }
        for (int j = 0; j < 10; ++j) {
            const int ks = q0 - 128 + 32 * j; const bool valid = (ks >= start && ks < end);
            const int buf = j & 1;
            if (valid) {
                *(LAS u32x4*)(lds + L_K + buf * KBUF + kl) = kreg;
                typedef u64 u64x2 __attribute__((ext_vector_type(2))); const u64x2 vv = __builtin_bit_cast(u64x2, vreg);
                *(LAS u64*)(lds + L_VT + buf * VBUF + vl) = vv.x; *(LAS u64*)(lds + L_VT + buf * VBUF + vl + 8) = vv.y;
            }
            { const int kn = ks + 32; if (j < 9 && kn >= start && kn < end) { kreg = *(const u32x4*)(Kb + (size_t)(kn + kkey) * 128 + kchunk * 8); vreg = *(const u32x4*)(Vt + (size_t)vch * M_TOK + kn + vpart * 8); } }
            __syncthreads();
            if (valid) {
                const LAS unsigned char* kb = lds + L_K + buf * KBUF + kvh * (32 * KROW);
                const LAS unsigned char* vb = lds + L_VT + buf * VBUF + kvh * (64 * VROW);
                if (j <= 8) tile(kb, vb, btw, qf[0], o[0][0], o[0][1], m[0], l[0], j, b, hi);
                if (j >= 1) tile(kb, vb, btw, qf[1], o[1][0], o[1][1], m[1], l[1], j - 1, b, hi);
            }
        }
#pragma unroll
        for (int i = 0; i < 2; ++i) {
            const float lt = l[i] + __shfl_xor(l[i], 32), inv = 1.0f / lt;
            float ss = 0.f;
#pragma unroll
            for (int r = 0; r < 16; ++r) { o[i][0][r] *= inv; o[i][1][r] *= inv; ss += o[i][0][r] * o[i][0][r] + o[i][1][r] * o[i][1][r]; }
            ss += __shfl_xor(ss, 32);
            if (hi == 0) ssq[(32 * i + b) * 8 + hq] = ss;
        }
        __syncthreads();
#pragma unroll
        for (int i = 0; i < 2; ++i) {
            const f32x4 s0 = *(const LAS f32x4*)(ssq + (32 * i + b) * 8), s1 = *(const LAS f32x4*)(ssq + (32 * i + b) * 8 + 4);
            const float tot = ((s0[0] + s0[1]) + (s0[2] + s0[3])) + ((s1[0] + s1[1]) + (s1[2] + s1[3]));
            const float rstd = rsqrtf(tot * (1.0f / 512.0f) + RMS_EPS);
#pragma unroll
            for (int nt = 0; nt < 2; ++nt)
#pragma unroll
                for (int rg = 0; rg < 4; ++rg) {
                    const u64 w = (u64)cvt_pk_bf16(o[i][nt][4 * rg] * rstd, o[i][nt][4 * rg + 1] * rstd) | ((u64)cvt_pk_bf16(o[i][nt][4 * rg + 2] * rstd, o[i][nt][4 * rg + 3] * rstd) << 32);
                    *(LAS u64*)(ost + (32 * i + b) * OROW + (32 * nt + 8 * rg + 4 * hi) * 2) = w;
                }
        }
        asm volatile("s_waitcnt lgkmcnt(0)" ::: "memory");
#pragma unroll
        for (int k = 0; k < 8; ++k) {
            const int rowl = (lane >> 3) + 8 * k, chunk = lane & 7; const size_t tok = (size_t)(q0 + rowl);
            const u32x4 v = *(const LAS u32x4*)(ost + rowl * OROW + chunk * 16);
            const u32x4 z = *(const u32x4*)(AZ + tok * 512 + hq * 64 + chunk * 8);
            u32x4 w;
            w.x = cvt_pk_bf16(bflo(v.x) * bflo(z.x), bfhi(v.x) * bfhi(z.x)); w.y = cvt_pk_bf16(bflo(v.y) * bflo(z.y), bfhi(v.y) * bfhi(z.y));
            w.z = cvt_pk_bf16(bflo(v.z) * bflo(z.z), bfhi(v.z) * bfhi(z.z)); w.w = cvt_pk_bf16(bflo(v.w) * bflo(z.w), bfhi(v.w) * bfhi(z.w));
            *(u32x4*)(MIX + tok * 1024 + 512 + hq * 64 + chunk * 8) = w;
        }
        asm volatile("s_waitcnt lgkmcnt(0)" ::: "memory");
    }
}
}


namespace ssm {
typedef float f32x2 __attribute__((ext_vector_type(2)));
typedef unsigned long long u64;
constexpr size_t GRP_T = 128 * 1024;
constexpr int T_APOW = 0, T_BBAR = 2 * 33 * 64 * 8, T_KTAB = T_BBAR + 2 * 64 * 16 * 8;
constexpr size_t GRP_W = 1024 * 1024; constexpr int W_1 = 0, W_2 = 256 * 1024;
static_assert(T_KTAB + 2 * 32 * 256 * 4 <= (int)GRP_T, "group table");

__device__ __forceinline__ void stage_a(LAS unsigned char* lds, int G) {
    const KA a; unsigned char* ws = a.ws();
    const float* lam_re = a.in(4); const float* lam_im = a.in(5); const float* log_step = a.in(6);
    const float* b_re = a.in(7); const float* b_im = a.in(8); const float* c_re = a.in(9); const float* c_im = a.in(10);
    LAS f32x2* l_apow = (LAS f32x2*)lds;
    LAS f32x2* l_coef = l_apow + 33 * 64;
    LAS f32x2* l_bbar = l_coef + 64;
    LAS f32x2* l_c = l_bbar + 1024;
    const int tid = threadIdx.x;
    for (int item = blockIdx.x; item < 256; item += G) {
        const int g = item >> 3, dir = (item >> 2) & 1, oct = item & 3, pg = dir * 32 + g;
        {
            const int p = tid & 63, tg = tid >> 6;
            const float lr = lam_re[pg * 64 + p], li = lam_im[pg * 64 + p], dt = expf(log_step[pg]);
            const float ang = li * dt, dec = lr * dt;
            for (int tau = tg; tau <= 32; tau += 8) {
                const float mag = expf(dec * (float)tau); float sn, cs; sincosf(ang * (float)tau, &sn, &cs);
                f32x2 v; v.x = mag * cs; v.y = mag * sn; l_apow[tau * 64 + p] = v;
            }
            if (tg == 0) {
                const float mag = expf(dec); float sn, cs; sincosf(ang, &sn, &cs);
                const float are = mag * cs, aim = mag * sn, den = lr * lr + li * li, nr = are - 1.0f;
                f32x2 v; v.x = (nr * lr + aim * li) / den; v.y = (aim * lr - nr * li) / den; l_coef[p] = v;
            }
        }
        __syncthreads();
        for (int e = tid; e < 1024; e += 512) {
            const int p = e >> 4, h = e & 15; const float br = b_re[(pg * 64 + p) * 16 + h], bi = b_im[(pg * 64 + p) * 16 + h]; const f32x2 co = l_coef[p];
            f32x2 v; v.x = co.x * br - co.y * bi; v.y = co.x * bi + co.y * br; l_bbar[e] = v;
        }
        for (int e = tid; e < 1024; e += 512) { const int h = e >> 6, p = e & 63; f32x2 v; v.x = c_re[(pg * 16 + h) * 64 + p]; v.y = c_im[(pg * 16 + h) * 64 + p]; l_c[e] = v; }
        __syncthreads();
        unsigned char* gt = ws + OFF_SSMT + (size_t)g * GRP_T;
        if (oct == 0) {
            f32x2* d_apow = (f32x2*)(gt + T_APOW) + dir * 33 * 64; f32x2* d_bbar = (f32x2*)(gt + T_BBAR) + dir * 1024;
            for (int e = tid; e < 33 * 64; e += 512) d_apow[e] = l_apow[e];
            for (int e = tid; e < 1024; e += 512) d_bbar[e] = l_bbar[e];
        }
        {
            const int tau = 8 * oct + (tid >> 6), h = (tid >> 2) & 15, hq4 = tid & 3;
            float acc[4] = {0.f, 0.f, 0.f, 0.f};
            for (int p = 0; p < 64; ++p) {
                const f32x2 cc = l_c[h * 64 + p], ap = l_apow[tau * 64 + p];
                const float ca_re = cc.x * ap.x - cc.y * ap.y, ca_im = cc.x * ap.y + cc.y * ap.x;
#pragma unroll
                for (int i = 0; i < 4; ++i) { const f32x2 bb = l_bbar[p * 16 + 4 * hq4 + i]; acc[i] += ca_re * bb.x - ca_im * bb.y; }
            }
            float* d_k = (float*)(gt + T_KTAB) + ((dir * 32 + tau) * 16 + h) * 16 + 4 * hq4;
            f32x4 o; o[0] = acc[0]; o[1] = acc[1]; o[2] = acc[2]; o[3] = acc[3]; *(f32x4*)d_k = o;
        }
        __syncthreads();
    }
}

__device__ __forceinline__ void stage_b(LAS unsigned char* lds, int G) {
    const KA a; unsigned char* ws = a.ws();
    const float* c_re = a.in(9); const float* c_im = a.in(10); const float* d_skip = a.in(11);
    LAS f32x2* l_apow = (LAS f32x2*)lds;
    LAS f32x2* l_bbar = l_apow + 2 * 33 * 64;
    LAS f32x2* l_c = l_bbar + 2 * 1024;
    LAS float* l_k = (LAS float*)(l_c + 2 * 1024);
    LAS float* l_d = l_k + 2 * 32 * 256;
    const int tid = threadIdx.x;
    for (int item = blockIdx.x; item < 256; item += G) {
        const int g = item >> 3, sub = item & 7;
        const unsigned char* gt = ws + OFF_SSMT + (size_t)g * GRP_T;
        for (int e = tid; e < (T_KTAB) / 16; e += 512) ((LAS u32x4*)l_apow)[e] = ((const u32x4*)gt)[e];
        for (int e = tid; e < 2 * 32 * 256 / 4; e += 512) ((LAS u32x4*)l_k)[e] = ((const u32x4*)(gt + T_KTAB))[e];
        for (int e = tid; e < 2048; e += 512) { const int dir = e >> 10, h = (e >> 6) & 15, p = e & 63; f32x2 v; v.x = c_re[((dir * 32 + g) * 16 + h) * 64 + p]; v.y = c_im[((dir * 32 + g) * 16 + h) * 64 + p]; l_c[e] = v; }
        if (tid < 16) l_d[tid] = d_skip[g * 16 + tid];
        __syncthreads();
        unsigned char* gw = ws + OFF_SSMW + (size_t)g * GRP_W;
#pragma unroll 1
        for (int i = 0; i < 4; ++i) {
            const int idx = tid + 512 * i, ks = idx >> 6, ln = idx & 63, n_l = ln & 31, hL = ln >> 5;
            const int n = 32 * sub + n_l, d = n >> 7, ri = (n >> 6) & 1, p = n & 63, tau = d ? ks : 31 - ks;
            const f32x2 ap = l_apow[(d * 33 + tau) * 64 + p];
            float v[8];
#pragma unroll
            for (int jj = 0; jj < 8; ++jj) { const f32x2 bb = l_bbar[(d * 64 + p) * 16 + 8 * hL + jj]; v[jj] = ri ? (ap.x * bb.y + ap.y * bb.x) : (ap.x * bb.x - ap.y * bb.y); }
            u32x4 w; w.x = cvt_pk_bf16(v[0], v[1]); w.y = cvt_pk_bf16(v[2], v[3]); w.z = cvt_pk_bf16(v[4], v[5]); w.w = cvt_pk_bf16(v[6], v[7]);
            *(u32x4*)(gw + W_1 + ((size_t)(ks * 8 + sub) * 64 + ln) * 16) = w;
        }
#pragma unroll 1
        for (int i = 0; i < 12; ++i) {
            const int idx = tid + 512 * i, nt2 = idx / 3072, rem = idx - nt2 * 3072, ks = rem >> 6, ln = rem & 63, n_l = ln & 31, hL = ln >> 5;
            const int nt = 2 * sub + nt2, n2 = 32 * nt + n_l, kt = n2 >> 4, hh = n2 & 15;
            float v[8];
            if (ks < 32) {
                const int j = ks;
#pragma unroll
                for (int jj = 0; jj < 8; ++jj) {
                    const int hp = 8 * hL + jj; float x = 0.f;
                    if (j <= kt) x += l_k[((kt - j) * 16 + hh) * 16 + hp];
                    if (j >= kt) x += l_k[((32 + j - kt) * 16 + hh) * 16 + hp];
                    if (j == kt && hh == hp) x += l_d[hh];
                    v[jj] = x;
                }
            } else {
#pragma unroll
                for (int jj = 0; jj < 8; ++jj) {
                    const int n = 16 * (ks - 32) + 8 * hL + jj, d = n >> 7, ri = (n >> 6) & 1, p = n & 63, tau = d ? 32 - kt : kt + 1;
                    const f32x2 ap = l_apow[(d * 33 + tau) * 64 + p], cc = l_c[(d * 16 + hh) * 64 + p];
                    v[jj] = ri ? -(cc.x * ap.y + cc.y * ap.x) : (cc.x * ap.x - cc.y * ap.y);
                }
            }
            u32x4 w; w.x = cvt_pk_bf16(v[0], v[1]); w.y = cvt_pk_bf16(v[2], v[3]); w.z = cvt_pk_bf16(v[4], v[5]); w.w = cvt_pk_bf16(v[6], v[7]);
            *(u32x4*)(gw + W_2 + ((size_t)(ks * 16 + nt) * 64 + ln) * 16) = w;
        }
        __syncthreads();
    }
}

constexpr int AROW = 272, ABUF = 128 * AROW, L_A = 0, L_FG = 2 * ABUF, FGROW = 528, L_XCH = L_FG + 128 * FGROW, YROW = 1040;
static_assert(L_XCH + 4096 <= 147456 && 128 * YROW <= L_XCH, "ssm LDS map");

__device__ __forceinline__ void a_load(u32x4 (&ar)[4], const bf16_t* A, int slice, int tid) {
#pragma unroll
    for (int i = 0; i < 4; ++i) { const int idx = tid + 512 * i, row = idx >> 4, piece = idx & 15; ar[i] = *(const u32x4*)(A + (size_t)row * 512 + slice * 128 + piece * 8); }
}
__device__ __forceinline__ void a_write(const u32x4 (&ar)[4], LAS unsigned char* buf, int tid) {
#pragma unroll
    for (int i = 0; i < 4; ++i) { const int idx = tid + 512 * i, row = idx >> 4, piece = idx & 15; *(LAS u32x4*)(buf + row * AROW + piece * 16) = ar[i]; }
}
__device__ __forceinline__ float gelu_fast(float x) { const float u2 = 1.5957691216057308f * (x + 0.044715f * x * x * x); return x * __builtin_amdgcn_rcpf(1.0f + __expf(-u2)); }

__device__ __forceinline__ void phase(LAS unsigned char* lds, int G) {
    const KA a; unsigned char* ws = a.ws();
    for (int item = blockIdx.x; item < 1024; item += G) {
        int tid = threadIdx.x; asm volatile("" : "+v"(tid));
        const int lane = tid & 63, w = __builtin_amdgcn_readfirstlane(tid >> 6), b = lane & 31, hi = lane >> 5;
        const int g = item & 31, unit = item >> 5, tok0 = unit * 4096; const bool pair = unit < 16;
        const bf16_t* A = (const bf16_t*)(ws + OFF_UGM) + ((size_t)g * M_TOK + tok0) * 16;
        const unsigned char* W1 = ws + OFF_SSMW + (size_t)g * GRP_W + W_1; const unsigned char* W2 = ws + OFF_SSMW + (size_t)g * GRP_W + W_2;
        u32x4 ar[4];
        const int q = w >> 1, mh = w & 1, d = q >> 1, ph = q & 1;
        f32x16 s_re[2], s_im[2];
#pragma unroll
        for (int mt = 0; mt < 2; ++mt)
#pragma unroll
            for (int r = 0; r < 16; ++r) { s_re[mt][r] = 0.f; s_im[mt][r] = 0.f; }
        {
            const int lcb = 32 * ((b >> 2) & 1) + (b & 3) + 4 * (b >> 3);
            const int arow0 = (64 * mh + lcb) * AROW + hi * 16;
            const unsigned char* wre = W1 + ((size_t)(4 * d + ph) * 64 + lane) * 16; const unsigned char* wim = W1 + ((size_t)(4 * d + 2 + ph) * 64 + lane) * 16;
            bf16x8 B0[4][2], B1[4][2];
#define SSM_LOADB1(dst, grp) do { _Pragma("unroll") for (int i_ = 0; i_ < 4; ++i_) { dst[i_][0] = *(const bf16x8*)(wre + (size_t)((grp) * 4 + i_) * 8192); dst[i_][1] = *(const bf16x8*)(wim + (size_t)((grp) * 4 + i_) * 8192); } } while (0)
#define SSM_COMP1(src, buf, kb) do { _Pragma("unroll") for (int i_ = 0; i_ < 4; ++i_) { _Pragma("unroll") for (int mt = 0; mt < 2; ++mt) { \
            const bf16x8 af = *(const LAS bf16x8*)((buf) + arow0 + mt * 16 * AROW + ((kb) + i_) * 32); \
            s_re[mt] = __builtin_amdgcn_mfma_f32_32x32x16_bf16(af, src[i_][0], s_re[mt], 0, 0, 0); s_im[mt] = __builtin_amdgcn_mfma_f32_32x32x16_bf16(af, src[i_][1], s_im[mt], 0, 0, 0); } } } while (0)
            a_load(ar, A, 0, tid);
            SSM_LOADB1(B0, 0);
#pragma unroll 1
            for (int s = 0; s < 4; ++s) {
                LAS unsigned char* buf = lds + L_A + (s & 1) * ABUF;
                a_write(ar, buf, tid);
                if (s < 3) a_load(ar, A, s + 1, tid);
                __syncthreads();
                SSM_LOADB1(B1, 2 * s + 1);
                SSM_COMP1(B0, buf, 0);
                if (s < 3) SSM_LOADB1(B0, 2 * s + 2);
                SSM_COMP1(B1, buf, 4);
            }
#undef SSM_LOADB1
#undef SSM_COMP1
        }
        {
            const f32x2 a32 = *(const f32x2*)(ws + OFF_SSMT + (size_t)g * GRP_T + T_APOW + (size_t)((d * 33 + 32) * 64 + 32 * ph + b) * 8);
            const float ar_ = a32.x, ai_ = a32.y;
            float rr = 0.f, ri_ = 0.f;
            if (d == 0) {
#pragma unroll
                for (int k = 0; k < 32; ++k) { const int mt = k >> 4, r = k & 15; const float er = s_re[mt][r], ei = s_im[mt][r]; s_re[mt][r] = rr; s_im[mt][r] = ri_;
                    const float nr = ar_ * rr - ai_ * ri_ + er, ni = ar_ * ri_ + ai_ * rr + ei; rr = nr; ri_ = ni; }
            } else {
#pragma unroll
                for (int k = 31; k >= 0; --k) { const int mt = k >> 4, r = k & 15; const float er = s_re[mt][r], ei = s_im[mt][r]; s_re[mt][r] = rr; s_im[mt][r] = ri_;
                    const float nr = ar_ * rr - ai_ * ri_ + er, ni = ar_ * ri_ + ai_ * rr + ei; rr = nr; ri_ = ni; }
            }
            LAS f32x2* xch = (LAS f32x2*)(lds + L_XCH);
            const int sg = 2 * mh + hi;
            { f32x2 v; v.x = rr; v.y = ri_; xch[(q * 4 + sg) * 32 + b] = v; }
            __syncthreads();
            float pr = ar_, pi = ai_;
#pragma unroll
            for (int i = 0; i < 5; ++i) { const float nr = pr * pr - pi * pi, ni = 2.f * pr * pi; pr = nr; pi = ni; }
            const f32x2 E0 = xch[(q * 4 + 0) * 32 + b], E1 = xch[(q * 4 + 1) * 32 + b], E2 = xch[(q * 4 + 2) * 32 + b], E3 = xch[(q * 4 + 3) * 32 + b];
            float cr = 0.f, ci = 0.f;
            if (d == 0) {
                float c1r = E0.x, c1i = E0.y;
                float c2r = pair ? 0.f : E1.x + (pr * c1r - pi * c1i), c2i = pair ? 0.f : E1.y + (pr * c1i + pi * c1r);
                float c3r = E2.x + (pr * c2r - pi * c2i), c3i = E2.y + (pr * c2i + pi * c2r);
                cr = sg == 0 ? 0.f : (sg == 1 ? c1r : (sg == 2 ? c2r : c3r)); ci = sg == 0 ? 0.f : (sg == 1 ? c1i : (sg == 2 ? c2i : c3i));
            } else {
                float c2r = E3.x, c2i = E3.y;
                float c1r = pair ? 0.f : E2.x + (pr * c2r - pi * c2i), c1i = pair ? 0.f : E2.y + (pr * c2i + pi * c2r);
                float c0r = E1.x + (pr * c1r - pi * c1i), c0i = E1.y + (pr * c1i + pi * c1r);
                cr = sg == 3 ? 0.f : (sg == 2 ? c2r : (sg == 1 ? c1r : c0r)); ci = sg == 3 ? 0.f : (sg == 2 ? c2i : (sg == 1 ? c1i : c0i));
            }
            LAS bf16_t* fg = (LAS bf16_t*)(lds + L_FG) + (32 * sg) * (FGROW / 2) + 128 * d + 32 * ph + b;
            if (d == 0) {
#pragma unroll
                for (int k = 0; k < 32; ++k) { const int mt = k >> 4, r = k & 15; fg[k * (FGROW / 2)] = f2bf(s_re[mt][r] + cr); fg[k * (FGROW / 2) + 64] = f2bf(s_im[mt][r] + ci);
                    const float nr = ar_ * cr - ai_ * ci, ni = ar_ * ci + ai_ * cr; cr = nr; ci = ni; }
            } else {
#pragma unroll
                for (int k = 31; k >= 0; --k) { const int mt = k >> 4, r = k & 15; fg[k * (FGROW / 2)] = f2bf(s_re[mt][r] + cr); fg[k * (FGROW / 2) + 64] = f2bf(s_im[mt][r] + ci);
                    const float nr = ar_ * cr - ai_ * ci, ni = ar_ * ci + ai_ * cr; cr = nr; ci = ni; }
            }
        }
        f32x16 acc[4][2];
#pragma unroll
        for (int mt = 0; mt < 4; ++mt)
#pragma unroll
            for (int r = 0; r < 16; ++r) { acc[mt][0][r] = 0.f; acc[mt][1][r] = 0.f; }
        {
            const int arow0 = b * AROW + hi * 16;
            const int frow0 = L_FG + b * FGROW + hi * 16;
            const unsigned char* wb = W2 + ((size_t)(2 * w) * 64 + lane) * 16;
            bf16x8 B0[4][2], B1[4][2];
#define SSM_LOADB2(dst, grp) do { _Pragma("unroll") for (int i_ = 0; i_ < 4; ++i_) { dst[i_][0] = *(const bf16x8*)(wb + (size_t)((grp) * 4 + i_) * 16384); dst[i_][1] = *(const bf16x8*)(wb + (size_t)((grp) * 4 + i_) * 16384 + 1024); } } while (0)
#define SSM_COMP2(src, base, rowstride, kb) do { _Pragma("unroll") for (int i_ = 0; i_ < 4; ++i_) { _Pragma("unroll") for (int mt = 0; mt < 4; ++mt) { \
            const bf16x8 af = *(const LAS bf16x8*)(lds + (base) + mt * 32 * (rowstride) + ((kb) + i_) * 32); \
            acc[mt][0] = __builtin_amdgcn_mfma_f32_32x32x16_bf16(af, src[i_][0], acc[mt][0], 0, 0, 0); acc[mt][1] = __builtin_amdgcn_mfma_f32_32x32x16_bf16(af, src[i_][1], acc[mt][1], 0, 0, 0); } } } while (0)
            a_load(ar, A, 0, tid);
            SSM_LOADB2(B0, 0);
#pragma unroll 1
            for (int s = 0; s < 4; ++s) {
                const int bo = L_A + (s & 1) * ABUF;
                a_write(ar, lds + bo, tid);
                if (s < 3) a_load(ar, A, s + 1, tid);
                __syncthreads();
                SSM_LOADB2(B1, 2 * s + 1);
                SSM_COMP2(B0, bo + arow0, AROW, 0);
                SSM_LOADB2(B0, 2 * s + 2);
                SSM_COMP2(B1, bo + arow0, AROW, 4);
            }
            SSM_LOADB2(B1, 9);  SSM_COMP2(B0, frow0, FGROW, 0);
            SSM_LOADB2(B0, 10); SSM_COMP2(B1, frow0, FGROW, 4);
            SSM_LOADB2(B1, 11); SSM_COMP2(B0, frow0, FGROW, 8);
            SSM_COMP2(B1, frow0, FGROW, 12);
#undef SSM_LOADB2
#undef SSM_COMP2
        }
        __syncthreads();
#pragma unroll
        for (int mt = 0; mt < 4; ++mt)
#pragma unroll
            for (int nt = 0; nt < 2; ++nt)
#pragma unroll
                for (int r = 0; r < 16; ++r) {
                    const int c = 32 * mt + (r & 3) + 8 * (r >> 2) + 4 * hi, n2 = 32 * (2 * w + nt) + b;
                    *(LAS bf16_t*)(lds + c * YROW + n2 * 2) = f2bf(gelu_fast(acc[mt][nt][r]));
                }
        __syncthreads();
        bf16_t* Gb = (bf16_t*)(ws + OFF_G);
#pragma unroll 4
        for (int i = 0; i < 16; ++i) {
            const int idx = tid + 512 * i, c = idx >> 6, j = (idx >> 1) & 31, half = idx & 1;
            const u32x4 v = *(const LAS u32x4*)(lds + c * YROW + j * 32 + half * 16);
            *(u32x4*)(Gb + (size_t)(tok0 + 32 * c + j) * 512 + 16 * g + 8 * half) = v;
        }
        __syncthreads();
    }
}
}

__device__ __forceinline__ void final_phase(int wave, int lane, int G) {
    const KA a; const float* rsq2 = (const float*)(a.ws() + OFF_RSQ2); const float* fw = a.in(19); float* outp = a.out();
    f32x4 w[4];
#pragma unroll
    for (int j = 0; j < 4; ++j) w[j] = *(const f32x4*)(fw + j * 256 + lane * 4);
    for (int t = 2 * (blockIdx.x * 8 + wave); t < M_TOK; t += G * 16) {
        const float rs0 = rsqrtf(rsq2[t] * (1.0f / DM) + RMS_EPS), rs1 = rsqrtf(rsq2[t + 1] * (1.0f / DM) + RMS_EPS);
        float* o = outp + (size_t)t * DM;
        f32x4 v[2][4];
#pragma unroll
        for (int rr = 0; rr < 2; ++rr)
#pragma unroll
            for (int j = 0; j < 4; ++j) v[rr][j] = *(const f32x4*)(o + rr * DM + j * 256 + lane * 4);
#pragma unroll
        for (int rr = 0; rr < 2; ++rr)
#pragma unroll
            for (int j = 0; j < 4; ++j) *(f32x4*)(o + rr * DM + j * 256 + lane * 4) = v[rr][j] * w[j] * (rr ? rs1 : rs0);
    }
}

constexpr int LDS_BYTES = 147456;
__global__ void __launch_bounds__(512, 2) mega_fwd(Args a_unused) {
    extern __shared__ __attribute__((aligned(16))) unsigned char lds_raw[];
    LAS unsigned char* lds = (LAS unsigned char*)lds_raw;
    cg::grid_group grid = cg::this_grid();
#define WAVE_ID __builtin_amdgcn_readfirstlane(threadIdx.x >> 6)
#define LANE_ID ((int)(threadIdx.x & 63))
#define GRID_N ((int)gridDim.x)

    if (threadIdx.x < 64) ((LAS unsigned*)(lds + 147200))[threadIdx.x] = 0u;
    __syncthreads();
    XcdBarrier bar;
    { const KA a; bar = xcd_barrier_post((unsigned*)(a.ws() + OFF_BAR), (volatile LAS unsigned*)(lds + 147200) + 8); }
    ssm::stage_a(lds, GRID_N);
    p0_prologue(lds, WAVE_ID, LANE_ID, GRID_N);
    grid.sync();
    ssm::stage_b(lds, GRID_N);
    {
        const KA a; unsigned char* ws = a.ws();
        pg8::Gemm g{(const bf16_t*)(ws + OFF_A), (const bf16_t*)(ws + OFF_WIN), M_TOK, NPROJ, DM}; pg8::StaticOrder S; S.init(M_TOK, NPROJ, GRID_N, (int)blockIdx.x);
        pg8::EpiIn E{(bf16_t*)(ws + OFF_UGM), (bf16_t*)(ws + OFF_SZ), (bf16_t*)(ws + OFF_Q), (bf16_t*)(ws + OFF_KB), (bf16_t*)(ws + OFF_VT), (bf16_t*)(ws + OFF_AZ)};
        pg8::gemm_phase<pg8::EpiIn, pg8::StaticOrder, true, true>(lds, g, S, E);
    }
    xcd_barrier(bar);
    ssm::phase(lds, GRID_N);
    att::phase(lds, GRID_N);
    xcd_barrier(bar);
    {
        const KA a; unsigned char* ws = a.ws();
        pg8::Gemm g{(const bf16_t*)(ws + OFF_G), (const bf16_t*)(ws + OFF_WGLU), M_TOK, 512, 512}; pg8::StaticOrder S; S.init(M_TOK, 512, GRID_N, (int)blockIdx.x);
        pg8::EpiGlu E{(const bf16_t*)(ws + OFF_G), (const bf16_t*)(ws + OFF_SZ), a.in(13), (bf16_t*)(ws + OFF_A), (float*)(ws + OFF_RSQ1)};
        pg8::gemm_phase<pg8::EpiGlu, pg8::StaticOrder, true, true>(lds, g, S, E);
    }
    xcd_barrier(bar);
    {
        const KA a; unsigned char* ws = a.ws();
        pg8::Gemm g{(const bf16_t*)(ws + OFF_A), (const bf16_t*)(ws + OFF_WOUT), M_TOK, DM, DM}; pg8::StaticOrder S; S.init(M_TOK, DM, GRID_N, (int)blockIdx.x);
        pg8::EpiOut E{a.in(0), a.in(1), a.out(), (const float*)(ws + OFF_RSQ1), (float*)(ws + OFF_RSQ2)};
        pg8::gemm_phase<pg8::EpiOut, pg8::StaticOrder, true, true>(lds, g, S, E);
    }
    xcd_barrier(bar);
    final_phase(WAVE_ID, LANE_ID, GRID_N);
}

extern "C" void kernel_launch(void* const* d_in, const int* in_sizes, int n_in, void* d_out, int out_size, void* d_ws, size_t ws_size, hipStream_t stream) {
    (void)in_sizes; (void)out_size;
    static int grid = 0;
    if (grid == 0) {
        if (n_in != 20 || ws_size < OFF_END) { fprintf(stderr, "kernel_launch: bad arguments (n_in %d, ws %zu < %zu)\n", n_in, ws_size, (size_t)OFF_END); grid = -1; return; }
        int dev = 0, cus = 0, per_cu = 0;
        if (hipGetDevice(&dev) != hipSuccess || hipDeviceGetAttribute(&cus, hipDeviceAttributeMultiprocessorCount, dev) != hipSuccess) { grid = -1; return; }
        if (hipFuncSetAttribute((const void*)mega_fwd, hipFuncAttributeMaxDynamicSharedMemorySize, LDS_BYTES) != hipSuccess) { fprintf(stderr, "kernel_launch: hipFuncSetAttribute failed\n"); grid = -1; return; }
        if (hipOccupancyMaxActiveBlocksPerMultiprocessor(&per_cu, (const void*)mega_fwd, 512, LDS_BYTES) != hipSuccess || per_cu < 1) { fprintf(stderr, "kernel_launch: occupancy query says %d\n", per_cu); grid = -1; return; }
        grid = cus * per_cu;
    }
    if (grid < 0) return;
    if (hipMemsetAsync((char*)d_ws + OFF_BAR, 0, 64 * 1024, stream) != hipSuccess) { fprintf(stderr, "kernel_launch: memset failed\n"); return; }
    Args a{};
    for (int i = 0; i < 20; ++i) a.in[i] = (const float*)d_in[i];
    a.out = (float*)d_out; a.ws = (unsigned char*)d_ws;
    void* args[] = {&a};
    hipError_t e = hipLaunchCooperativeKernel((const void*)mega_fwd, dim3(grid), dim3(512), args, LDS_BYTES, stream);
    if (e != hipSuccess) fprintf(stderr, "cooperative launch failed: %s (grid %d)\n", hipGetErrorString(e), grid);
}
```
